# Optimizing an MI355X kernel written in HIP

```python
import math
import jax, jax.numpy as jnp
from jax import lax
import numpy as np

D_MODEL = 1024
BATCH = 2
SEQ = 16384
DEPTH = 4

MEM_LEN = 256
HEAD_DIM = 64
DIFF_HEADS = 4
DIFF_QK = 32
DIFF_V = 2 * DIFF_QK
MLA_HEADS = 4
MLA_Q_RANK = 256
MLA_KV_RANK = 128
MLA_NOPE = 64
MLA_ROPE = 32
MLA_V = 64
SWA_Q_HEADS = 8
SWA_KV_HEADS = 2
SWA_GROUP = SWA_Q_HEADS // SWA_KV_HEADS
SWA_WINDOW = 128
D_MIX = DIFF_HEADS * DIFF_V + MLA_HEADS * MLA_V + SWA_Q_HEADS * HEAD_DIM
IN_SIZES = [DIFF_HEADS * 2 * DIFF_QK, DIFF_HEADS * 2 * DIFF_QK, DIFF_HEADS * DIFF_V,
            MLA_Q_RANK, MLA_KV_RANK, MLA_ROPE,
            SWA_Q_HEADS * HEAD_DIM, SWA_KV_HEADS * HEAD_DIM, SWA_KV_HEADS * HEAD_DIM]
D_IN = sum(IN_SIZES)
IN_SPLITS = [int(v) for v in np.cumsum(IN_SIZES)[:-1]]
X_HEADS = 4
X_HEAD_DIM = D_MODEL // X_HEADS
D_FF = -(-8 * D_MODEL // (3 * 256)) * 256

N_ALIBI = DIFF_HEADS + SWA_Q_HEADS
QBLK = 128
ROPE_THETA = 10000.0
EPS = 1e-6

kernel_name = "hymba_style_hybrid_encoder"


def rmsnorm(x, g):
    xf = x.astype(jnp.float32)
    y = xf * lax.rsqrt(jnp.mean(xf * xf, axis=-1, keepdims=True) + EPS)
    return (y * g.astype(jnp.float32)).astype(x.dtype)


def rope(x, pos):
    half = x.shape[-1] // 2
    inv = ROPE_THETA ** (-jnp.arange(half, dtype=jnp.float32) / half)
    ang = pos.astype(jnp.float32)[..., None] * inv
    ang = ang.reshape(ang.shape[:2] + (1,) * (x.ndim - 3) + (half,))
    cos, sin = jnp.cos(ang), jnp.sin(ang)
    xf = x.astype(jnp.float32)
    x1, x2 = xf[..., :half], xf[..., half:]
    return jnp.concatenate([x1 * cos - x2 * sin, x1 * sin + x2 * cos], axis=-1).astype(x.dtype)


def alibi_slopes():
    return 2.0 ** (-8.0 * jnp.arange(1, N_ALIBI + 1, dtype=jnp.float32) / N_ALIBI)


def diff_attention(q, k, v, pos, slopes, lam):
    B, S, H, _ = q.shape
    nblk = S // QBLK
    scale = 1.0 / math.sqrt(DIFF_QK)
    qb = q.reshape(B, nblk, QBLK, H, 2, DIFF_QK).swapaxes(0, 1)
    pb = pos.reshape(B, nblk, QBLK).swapaxes(0, 1)
    k2 = k.reshape(B, S, H, 2, DIFF_QK)

    def one_block(args):
        qi, pi = args
        s = jnp.einsum('bqhmd,bshmd->bmhqs', qi, k2).astype(jnp.float32) * scale
        dist = jnp.abs(pi[:, :, None] - pos[:, None, :]).astype(jnp.float32)
        s = s - slopes[None, None, :, None, None] * dist[:, None, None]
        p = jax.nn.softmax(s, axis=-1)
        a = p[:, 0] - lam * p[:, 1]
        return jnp.einsum('bhqs,bshd->bqhd', a.astype(v.dtype), v)

    out = lax.map(one_block, (qb, pb))
    return out.swapaxes(0, 1).reshape(B, S, H, DIFF_V)


def mla_attention(q, k, v):
    B, S, H, D = q.shape
    nblk = S // QBLK
    scale = 1.0 / math.sqrt(D)
    qb = q.reshape(B, nblk, QBLK, H, D).swapaxes(0, 1)

    def one_block(qi):
        s = jnp.einsum('bqhd,bshd->bhqs', qi, k).astype(jnp.float32) * scale
        p = jax.nn.softmax(s, axis=-1)
        return jnp.einsum('bhqs,bshd->bqhd', p.astype(v.dtype), v)

    out = lax.map(one_block, qb)
    return out.swapaxes(0, 1).reshape(B, S, H * MLA_V)


def swa_attention(q, k, v, pos, slopes, sinks):
    B, S = q.shape[:2]
    W = SWA_WINDOW
    nblk = S // W
    scale = 1.0 / math.sqrt(HEAD_DIM)

    def band(t):
        pad = [(0, 0), (W, W)] + [(0, 0)] * (t.ndim - 2)
        tp = jnp.pad(t, pad).reshape((t.shape[0], nblk + 2, W) + t.shape[2:])
        return jnp.concatenate([tp[:, :-2], tp[:, 1:-1], tp[:, 2:]], axis=2)

    kb, vb, pkb = band(k), band(v), band(pos)
    valid = band(jnp.ones((1, S), dtype=bool))
    qg = q.reshape(B, nblk, W, SWA_KV_HEADS, SWA_GROUP, HEAD_DIM)
    s = jnp.einsum('bnqkgd,bnskd->bnkgqs', qg, kb).astype(jnp.float32) * scale
    pq = pos.reshape(B, nblk, W)
    dist = jnp.abs(pq[..., :, None] - pkb[..., None, :]).astype(jnp.float32)
    s = s - slopes.reshape(SWA_KV_HEADS, SWA_GROUP)[:, :, None, None] * dist[:, :, None, None]
    offs = jnp.arange(3 * W)[None, :] - W - jnp.arange(W)[:, None]
    mask = (jnp.abs(offs) <= W)[None, None] & valid[:, :, None, :]
    s = jnp.where(mask[:, :, None, None], s, jnp.finfo(jnp.float32).min)
    sink = sinks.astype(jnp.float32).reshape(SWA_KV_HEADS, SWA_GROUP)[:, :, None, None]
    m = jnp.maximum(jnp.max(s, axis=-1, keepdims=True), sink)
    e = jnp.exp(s - m)
    p = e / (jnp.sum(e, axis=-1, keepdims=True) + jnp.exp(sink - m))
    o = jnp.einsum('bnkgqs,bnskd->bnqkgd', p.astype(v.dtype), vb)
    return o.reshape(B, S, SWA_Q_HEADS * HEAD_DIM)


def cross_attention(h, mem_n, w_q, w_kv, w_o):
    B, S, _ = h.shape
    M = mem_n.shape[1]
    q = (h @ w_q).reshape(B, S, X_HEADS, X_HEAD_DIM)
    k, v = jnp.split(mem_n @ w_kv, 2, axis=-1)
    k = k.reshape(B, M, X_HEADS, X_HEAD_DIM)
    v = v.reshape(B, M, X_HEADS, X_HEAD_DIM)
    s = jnp.einsum('bqhd,bmhd->bhqm', q, k).astype(jnp.float32) / math.sqrt(X_HEAD_DIM)
    p = jax.nn.softmax(s, axis=-1)
    o = jnp.einsum('bhqm,bmhd->bqhd', p.astype(v.dtype), v).reshape(B, S, D_MODEL)
    return o @ w_o


def setup_inputs(seed: int = 0) -> dict:
    key = jax.random.key(seed)
    ks = jax.random.split(key, 32)
    f32 = jnp.float32

    def w(k, shape, fan_in):
        return jax.random.normal(k, shape, f32) * fan_in ** -0.5

    def gain(k, shape):
        return 1.0 + 0.02 * jax.random.normal(k, shape, f32)

    offset = jax.random.randint(ks[2], (BATCH, 1), 0, 1024, dtype=jnp.int32)
    positions = offset + jnp.arange(SEQ, dtype=jnp.int32)[None, :]
    return {
        "x": jax.random.normal(ks[0], (BATCH, SEQ, D_MODEL), f32),
        "mem": jax.random.normal(ks[1], (BATCH, MEM_LEN, D_MODEL), f32),
        "positions": positions,
        "g_mix_pre": gain(ks[3], (DEPTH, D_MODEL)),
        "g_mix_post": gain(ks[4], (DEPTH, D_MODEL)),
        "w_in": w(ks[5], (DEPTH, D_MODEL, D_IN), D_MODEL),
        "diff_lambda": 0.1 * jax.random.normal(ks[6], (DEPTH, 4, DIFF_QK), f32),
        "diff_head_g": gain(ks[7], (DEPTH, DIFF_V)),
        "mla_q_norm_g": gain(ks[8], (DEPTH, MLA_Q_RANK)),
        "mla_w_q_up": w(ks[9], (DEPTH, MLA_Q_RANK, MLA_HEADS * (MLA_NOPE + MLA_ROPE)), MLA_Q_RANK),
        "mla_kv_norm_g": gain(ks[10], (DEPTH, MLA_KV_RANK)),
        "mla_w_kv_up": w(ks[11], (DEPTH, MLA_KV_RANK, MLA_HEADS * (MLA_NOPE + MLA_V)), MLA_KV_RANK),
        "swa_sinks": 0.5 * jax.random.normal(ks[12], (DEPTH, SWA_Q_HEADS), f32),
        "w_out": w(ks[13], (DEPTH, D_MIX, D_MODEL), D_MIX),
        "g_x_pre": gain(ks[14], (DEPTH, D_MODEL)),
        "g_x_mem": gain(ks[15], (DEPTH, D_MODEL)),
        "g_x_post": gain(ks[16], (DEPTH, D_MODEL)),
        "w_xq": w(ks[17], (DEPTH, D_MODEL, D_MODEL), D_MODEL),
        "w_xkv": w(ks[18], (DEPTH, D_MODEL, 2 * D_MODEL), D_MODEL),
        "w_xo": w(ks[19], (DEPTH, D_MODEL, D_MODEL), D_MODEL),
        "g_ffn_pre": gain(ks[20], (DEPTH, D_MODEL)),
        "g_ffn_post": gain(ks[21], (DEPTH, D_MODEL)),
        "w_ffn_in": w(ks[22], (DEPTH, D_MODEL, 2 * D_FF), D_MODEL),
        "w_ffn_out": w(ks[23], (DEPTH, D_FF, D_MODEL), D_FF),
    }


def reference(x, mem, positions, g_mix_pre, g_mix_post, w_in, diff_lambda, diff_head_g,
              mla_q_norm_g, mla_w_q_up, mla_kv_norm_g, mla_w_kv_up, swa_sinks, w_out,
              g_x_pre, g_x_mem, g_x_post, w_xq, w_xkv, w_xo,
              g_ffn_pre, g_ffn_post, w_ffn_in, w_ffn_out):
    B, S, _ = x.shape
    slopes = alibi_slopes()
    swa_slopes = slopes[:SWA_Q_HEADS]
    diff_slopes = slopes[SWA_Q_HEADS:]

    for l in range(DEPTH):
        h = rmsnorm(x, g_mix_pre[l])
        (a_q, a_k, a_v, b_cq, b_ckv, b_kr, c_q, c_k, c_v) = jnp.split(h @ w_in[l], IN_SPLITS, axis=-1)

        lam_init = 0.8 - 0.6 * math.exp(-0.3 * l)
        lp = diff_lambda[l].astype(jnp.float32)
        lam = jnp.exp(jnp.sum(lp[0] * lp[1])) - jnp.exp(jnp.sum(lp[2] * lp[3])) + lam_init
        o_a = diff_attention(a_q.reshape(B, S, DIFF_HEADS, 2 * DIFF_QK),
                             a_k.reshape(B, S, DIFF_HEADS, 2 * DIFF_QK),
                             a_v.reshape(B, S, DIFF_HEADS, DIFF_V),
                             positions, diff_slopes, lam)
        o_a = (rmsnorm(o_a, diff_head_g[l]) * (1.0 - lam_init)).reshape(B, S, DIFF_HEADS * DIFF_V)

        qb = (rmsnorm(b_cq, mla_q_norm_g[l]) @ mla_w_q_up[l]).reshape(B, S, MLA_HEADS, MLA_NOPE + MLA_ROPE)
        qb = jnp.concatenate([qb[..., :MLA_NOPE], rope(qb[..., MLA_NOPE:], positions)], axis=-1)
        kvb = (rmsnorm(b_ckv, mla_kv_norm_g[l]) @ mla_w_kv_up[l]).reshape(B, S, MLA_HEADS, MLA_NOPE + MLA_V)
        k_rope = jnp.broadcast_to(rope(b_kr, positions)[:, :, None, :], (B, S, MLA_HEADS, MLA_ROPE))
        kb = jnp.concatenate([kvb[..., :MLA_NOPE], k_rope], axis=-1)
        o_b = mla_attention(qb, kb, kvb[..., MLA_NOPE:])

        o_c = swa_attention(c_q.reshape(B, S, SWA_Q_HEADS, HEAD_DIM),
                            c_k.reshape(B, S, SWA_KV_HEADS, HEAD_DIM),
                            c_v.reshape(B, S, SWA_KV_HEADS, HEAD_DIM),
                            positions, swa_slopes, swa_sinks[l])

        mix = jnp.concatenate([o_a, o_b, o_c], axis=-1) @ w_out[l]
        x = x + rmsnorm(mix, g_mix_post[l])

        xo = cross_attention(rmsnorm(x, g_x_pre[l]), rmsnorm(mem, g_x_mem[l]), w_xq[l], w_xkv[l], w_xo[l])
        x = x + rmsnorm(xo, g_x_post[l])

        gate, up = jnp.split(rmsnorm(x, g_ffn_pre[l]) @ w_ffn_in[l], 2, axis=-1)
        f = (jax.nn.silu(gate) * up) @ w_ffn_out[l]
        x = x + rmsnorm(f, g_ffn_post[l])

    return x
```

```cpp
#include <hip/hip_runtime.h>
#include <hip/hip_cooperative_groups.h>
#include <stdint.h>
#include <stdio.h>
namespace cg = cooperative_groups;

#ifndef SINGLE_LAUNCH
#define SINGLE_LAUNCH 0
#endif

#ifndef ATT_SEL
#define ATT_SEL 7
#endif
#define DI __device__ __forceinline__
typedef unsigned short bf16_t;
typedef __attribute__((ext_vector_type(8))) short bf16x8;
typedef __attribute__((ext_vector_type(16))) float f32x16;
typedef __bf16 bf16x2_t __attribute__((ext_vector_type(2)));
typedef float f32x2_t __attribute__((ext_vector_type(2)));
typedef uint32_t u32x4 __attribute__((ext_vector_type(4)));

constexpr int SEQ = 16384, NTOK = 32768, DM = 1024, DFF = 2816, DIN = 1952, DEPTH = 4;
constexpr float LOG2E = 1.4426950408889634f;
constexpr float EPSN = 1e-6f;
constexpr int NTHREADS = 256;
constexpr int SMEM_BYTES = 73728;

constexpr size_t MiB = 1ull << 20;
constexpr size_t OFF_W = 0, OFF_H = 33 * MiB, OFF_Y = 97 * MiB, OFF_BIG = 225 * MiB, OFF_SM = 417 * MiB;
constexpr size_t WO_IN = 0;
constexpr size_t WO_QUP = WO_IN + 2048 * 1024;
constexpr size_t WO_KVUP = WO_QUP + 384 * 256;
constexpr size_t WO_OUT = WO_KVUP + 512 * 128;
constexpr size_t WO_XQ = WO_OUT + 1024 * 1024;
constexpr size_t WO_XKV = WO_XQ + 1024 * 1024;
constexpr size_t WO_XO = WO_XKV + 2048 * 1024;
constexpr size_t WO_FI = WO_XO + 1024 * 1024;
constexpr size_t WO_FO = WO_FI + 5632 * 1024;

struct Params {
  const float* x_in; const float* mem; const int* pos;
  const float* g_mix_pre; const float* g_mix_post; const float* w_in; const float* diff_lambda; const float* diff_head_g;
  const float* mla_q_norm_g; const float* mla_w_q_up; const float* mla_kv_norm_g; const float* mla_w_kv_up;
  const float* swa_sinks; const float* w_out; const float* g_x_pre; const float* g_x_mem; const float* g_x_post;
  const float* w_xq; const float* w_xkv; const float* w_xo; const float* g_ffn_pre; const float* g_ffn_post;
  const float* w_ffn_in; const float* w_ffn_out;
  float* xres;
  char* ws;
  int phase_begin, phase_end, pad0, pad1;
};

DI uint32_t pack2(float a, float b) { f32x2_t v = {a, b}; bf16x2_t r = __builtin_convertvector(v, bf16x2_t); return __builtin_bit_cast(uint32_t, r); }
DI bf16_t tobf(float a) { return (bf16_t)(pack2(a, 0.f) & 0xffffu); }
DI float frombf(uint32_t v) { return __uint_as_float(v << 16); }
DI f32x16 mfma32(bf16x8 a, bf16x8 b, f32x16 c) { return __builtin_amdgcn_mfma_f32_32x32x16_bf16(a, b, c, 0, 0, 0); }
DI int opaque_tid() { int t = threadIdx.x; asm volatile("" : "+v"(t)); return t; }
DI float fexp2(float x) { return __builtin_amdgcn_exp2f(x); }
DI float wave_sum(float v) {
#pragma unroll
  for (int o = 32; o >= 1; o >>= 1) v += __shfl_xor(v, o);
  return v;
}
DI float rope_inv(int i) { return exp2f(-(float)i * 0.8304820237218406f); }
DI void sincos_red(float ang, float& s, float& c) {
  double a = (double)ang;
  double k = rint(a * 0.15915494309189535);
  float r = (float)(a - k * 6.283185307179586);
  s = sinf(r); c = cosf(r);
}
DI void store_vt(bf16_t* rowbase, int tok32, int g, int h, float v0, float v1, float v2, float v3) {
  int pos = tok32 + 16 * (g >> 1) + 8 * h + 4 * (g & 1);
  uint2 u; u.x = pack2(v0, v1); u.y = pack2(v2, v3);
  *(uint2*)(rowbase + pos) = u;
}

DI void convert_weights(const Params& p, int l, char* smem) {
  const int tid = opaque_tid();
  bf16_t* W = (bf16_t*)(p.ws + OFF_W);
  float* tile = (float*)smem;
  for (int t = blockIdx.x; t < 7840; t += gridDim.x) {
    const float* src; int K, N, lt, mode = 0; bf16_t* dst;
    if (t < 976)       { src = p.w_in + (size_t)l * 1024 * 1952;      K = 1024; N = 1952; dst = W + WO_IN;   lt = t; }
    else if (t < 1024) { src = p.mla_w_q_up + (size_t)l * 256 * 384;  K = 256;  N = 384;  dst = W + WO_QUP;  lt = t - 976; }
    else if (t < 1056) { src = p.mla_w_kv_up + (size_t)l * 128 * 512; K = 128;  N = 512;  dst = W + WO_KVUP; lt = t - 1024; }
    else if (t < 1568) { src = p.w_out + (size_t)l * 1024 * 1024;     K = 1024; N = 1024; dst = W + WO_OUT;  lt = t - 1056; }
    else if (t < 2080) { src = p.w_xq + (size_t)l * 1024 * 1024;      K = 1024; N = 1024; dst = W + WO_XQ;   lt = t - 1568; }
    else if (t < 3104) { src = p.w_xkv + (size_t)l * 1024 * 2048;     K = 1024; N = 2048; dst = W + WO_XKV;  lt = t - 2080; }
    else if (t < 3616) { src = p.w_xo + (size_t)l * 1024 * 1024;      K = 1024; N = 1024; dst = W + WO_XO;   lt = t - 3104; }
    else if (t < 6432) { src = p.w_ffn_in + (size_t)l * 1024 * 5632;  K = 1024; N = 5632; dst = W + WO_FI;   lt = t - 3616; mode = 1; }
    else               { src = p.w_ffn_out + (size_t)l * 2816 * 1024; K = 2816; N = 1024; dst = W + WO_FO;   lt = t - 6432; }
    const int nNt = N >> 5;
    const int k0 = (lt / nNt) * 64, n0 = (lt % nNt) * 32;
#pragma unroll
    for (int it = 0; it < 8; ++it) {
      int i = it * 8 + (tid >> 5), j = tid & 31;
      tile[i * 33 + j] = src[(size_t)(k0 + i) * N + n0 + j];
    }
    __syncthreads();
#pragma unroll
    for (int it = 0; it < 4; ++it) {
      int jn = it * 8 + (tid >> 5), kp = tid & 31;
      float a = tile[(2 * kp) * 33 + jn], b = tile[(2 * kp + 1) * 33 + jn];
      int n = n0 + jn, drow = n;
      if (mode == 1) drow = (n < DFF) ? ((n >> 5) * 64 + (n & 31)) : ((((n - DFF) >> 5) * 64) + 32 + ((n - DFF) & 31));
      *(uint32_t*)(dst + (size_t)drow * K + k0 + 2 * kp) = pack2(a, b);
    }
    __syncthreads();
  }
  uint32_t* padp = (uint32_t*)(W + WO_IN + (size_t)1952 * 1024);
  for (int i = blockIdx.x * NTHREADS + tid; i < 49152; i += gridDim.x * NTHREADS) padp[i] = 0u;
}

template <bool RES, bool NORM2>
DI void row_op(const float* xsrc, const float* Yrow, const float* gpost, float* xdst, const float* gnext, bf16_t* Hout, int lane) {
  float4 xv[4];
#pragma unroll
  for (int j = 0; j < 4; ++j) xv[j] = *(const float4*)(xsrc + j * 256 + lane * 4);
  if (RES) {
    float4 yv[4]; float ss = 0.f;
#pragma unroll
    for (int j = 0; j < 4; ++j) { yv[j] = *(const float4*)(Yrow + j * 256 + lane * 4); ss += yv[j].x * yv[j].x + yv[j].y * yv[j].y + yv[j].z * yv[j].z + yv[j].w * yv[j].w; }
    ss = wave_sum(ss);
    float rs = rsqrtf(ss * (1.f / 1024.f) + EPSN);
#pragma unroll
    for (int j = 0; j < 4; ++j) {
      float4 g = *(const float4*)(gpost + j * 256 + lane * 4);
      xv[j].x += yv[j].x * rs * g.x; xv[j].y += yv[j].y * rs * g.y; xv[j].z += yv[j].z * rs * g.z; xv[j].w += yv[j].w * rs * g.w;
      *(float4*)(xdst + j * 256 + lane * 4) = xv[j];
    }
  }
  if (NORM2) {
    float ss = 0.f;
#pragma unroll
    for (int j = 0; j < 4; ++j) ss += xv[j].x * xv[j].x + xv[j].y * xv[j].y + xv[j].z * xv[j].z + xv[j].w * xv[j].w;
    ss = wave_sum(ss);
    float rs = rsqrtf(ss * (1.f / 1024.f) + EPSN);
#pragma unroll
    for (int j = 0; j < 4; ++j) {
      float4 g = *(const float4*)(gnext + j * 256 + lane * 4);
      uint2 u; u.x = pack2(xv[j].x * rs * g.x, xv[j].y * rs * g.y); u.y = pack2(xv[j].z * rs * g.z, xv[j].w * rs * g.w);
      *(uint2*)(Hout + j * 256 + lane * 4) = u;
    }
  }
}

enum { EPI_F32 = 0, EPI_PROJ, EPI_XKV, EPI_QUP, EPI_KVUP, EPI_XQ, EPI_SWIGLU };

template <int EPI>
DI void gemm_epilogue(const Params& p, const f32x16 (&acc)[2][2], int m0, int n0, int wm, int wn, int l31, int h) {
  bf16_t* PROJ = (bf16_t*)(p.ws + OFF_BIG);
#pragma unroll
  for (int i = 0; i < 2; ++i) {
    const int rb = m0 + wm * 64 + i * 32;
#pragma unroll
    for (int jn = 0; jn < 2; ++jn) {
      const int cb = n0 + wn * 64 + jn * 32;
      const int col = cb + l31;
      if (EPI == EPI_F32) {
        float* Y = (float*)(p.ws + OFF_Y);
#pragma unroll
        for (int r = 0; r < 16; ++r) { int row = rb + 8 * (r >> 2) + 4 * h + (r & 3); Y[(size_t)row * 1024 + col] = acc[i][jn][r]; }
      } else if (EPI == EPI_XQ) {
        const float sc = LOG2E * 0.0625f;
#pragma unroll
        for (int r = 0; r < 16; ++r) { int row = rb + 8 * (r >> 2) + 4 * h + (r & 3); PROJ[(size_t)row * 1024 + col] = tobf(acc[i][jn][r] * sc); }
      } else if (EPI == EPI_PROJ) {
        if (cb >= DIN) continue;
        if (cb >= 512 && cb < 768) {
          bf16_t* VtA = (bf16_t*)(p.ws + OFF_Y + 72 * MiB);
          int c2 = col - 512; int b = rb / SEQ, tok32 = rb % SEQ;
          bf16_t* rowp = VtA + ((size_t)(b * 4 + (c2 >> 6)) * 64 + (c2 & 63)) * SEQ;
#pragma unroll
          for (int g = 0; g < 4; ++g) store_vt(rowp, tok32, g, h, acc[i][jn][4 * g], acc[i][jn][4 * g + 1], acc[i][jn][4 * g + 2], acc[i][jn][4 * g + 3]);
        } else if (cb >= 1824) {
          bf16_t* VtC = (bf16_t*)(p.ws + OFF_Y + 104 * MiB);
          int c2 = col - 1824; int b = rb / SEQ, tok32 = rb % SEQ;
          bf16_t* rowp = VtC + ((size_t)(b * 2 + (c2 >> 6)) * 64 + (c2 & 63)) * SEQ;
#pragma unroll
          for (int g = 0; g < 4; ++g) store_vt(rowp, tok32, g, h, acc[i][jn][4 * g], acc[i][jn][4 * g + 1], acc[i][jn][4 * g + 2], acc[i][jn][4 * g + 3]);
        } else {
          float sc = 1.f;
          if (cb < 256) sc = LOG2E * 0.17677669529663687f;
          else if (cb >= 1184 && cb < 1696) sc = LOG2E * 0.125f;
#pragma unroll
          for (int r = 0; r < 16; ++r) { int row = rb + 8 * (r >> 2) + 4 * h + (r & 3); PROJ[(size_t)row * 2048 + col] = tobf(acc[i][jn][r] * sc); }
        }
      } else if (EPI == EPI_XKV) {
        if (cb < 1024) {
          bf16_t* KX = (bf16_t*)(p.ws + OFF_SM + 1 * MiB);
#pragma unroll
          for (int r = 0; r < 16; ++r) { int row = rb + 8 * (r >> 2) + 4 * h + (r & 3); KX[(size_t)row * 1024 + col] = tobf(acc[i][jn][r]); }
        } else {
          bf16_t* VtX = (bf16_t*)(p.ws + OFF_SM + 2 * MiB);
          int c2 = col - 1024; int b = rb >> 8, tok32 = rb & 255;
          bf16_t* rowp = VtX + ((size_t)(b * 4 + (c2 >> 8)) * 256 + (c2 & 255)) * 256;
#pragma unroll
          for (int g = 0; g < 4; ++g) store_vt(rowp, tok32, g, h, acc[i][jn][4 * g], acc[i][jn][4 * g + 1], acc[i][jn][4 * g + 2], acc[i][jn][4 * g + 3]);
        }
      } else if (EPI == EPI_QUP) {
        bf16_t* QB = (bf16_t*)(p.ws + OFF_Y + 24 * MiB);
        const float sc = LOG2E * 0.10206207261596575f;
        const bool ropeblk = (cb % 96) == 64;
        const float inv = rope_inv(l31 & 15);
#pragma unroll
        for (int r = 0; r < 16; ++r) {
          int row = rb + 8 * (r >> 2) + 4 * h + (r & 3);
          float v = acc[i][jn][r] * sc;
          if (ropeblk) {
            float other = __shfl_xor(v, 16);
            float ang = (float)p.pos[row] * inv;
            float s, c; sincos_red(ang, s, c);
            v = (l31 < 16) ? (v * c - other * s) : (other * s + v * c);
          }
          QB[(size_t)row * 384 + col] = tobf(v);
        }
      } else if (EPI == EPI_KVUP) {
        int head = cb >> 7, within = cb & 127;
        if (within < 64) {
          bf16_t* KB = (bf16_t*)(p.ws + OFF_Y + 48 * MiB);
#pragma unroll
          for (int r = 0; r < 16; ++r) { int row = rb + 8 * (r >> 2) + 4 * h + (r & 3); KB[(size_t)row * 384 + head * 96 + within + l31] = tobf(acc[i][jn][r]); }
        } else {
          bf16_t* VtB = (bf16_t*)(p.ws + OFF_Y + 88 * MiB);
          int dv = within - 64 + l31; int b = rb / SEQ, tok32 = rb % SEQ;
          bf16_t* rowp = VtB + ((size_t)(b * 4 + head) * 64 + dv) * SEQ;
#pragma unroll
          for (int g = 0; g < 4; ++g) store_vt(rowp, tok32, g, h, acc[i][jn][4 * g], acc[i][jn][4 * g + 1], acc[i][jn][4 * g + 2], acc[i][jn][4 * g + 3]);
        }
      } else if (EPI == EPI_SWIGLU) {
        if (jn == 0) {
          bf16_t* F = (bf16_t*)(p.ws + OFF_BIG);
          const int oc = ((n0 + wn * 64) >> 1) + l31;
#pragma unroll
          for (int r = 0; r < 16; ++r) {
            int row = rb + 8 * (r >> 2) + 4 * h + (r & 3);
            float g = acc[i][0][r], u = acc[i][1][r];
            float sg = g / (1.f + fexp2(-g * LOG2E));
            F[(size_t)row * DFF + oc] = tobf(sg * u);
          }
        }
      }
    }
  }
}

template <int EPI>
DI void gemm_phase(const Params& p, char* smem, const bf16_t* A, int lda, const bf16_t* Wt, int K, int nM, int nN, int xcdmap) {
  const int tid = opaque_tid(), lane = tid & 63, w = tid >> 6, l31 = lane & 31, h = lane >> 5;
  const int wm = w >> 1, wn = w & 1;
  bf16_t* sm = (bf16_t*)smem;
  constexpr int LDSROW = 72;
  constexpr int BUFE = 256 * LDSROW;
  const int nk = K >> 6;
  int total, start, step;
  const int xcd = blockIdx.x & 7;
  if (xcdmap) { total = (nM >> 3) * nN; start = blockIdx.x >> 3; step = gridDim.x >> 3; }
  else { total = nM * nN; start = blockIdx.x; step = gridDim.x; }
  for (int j = start; j < total; j += step) {
    int mt, nt;
    if (xcdmap) { int g = j / (8 * nN), r = j % (8 * nN); nt = r >> 3; mt = xcd * (nM >> 3) + g * 8 + (r & 7); }
    else { mt = j / nN; nt = j % nN; }
    const int m0 = mt * 128, n0 = nt * 128;
    const bf16_t* Ag = A + (size_t)m0 * lda;
    const bf16_t* Bg = Wt + (size_t)n0 * K;
    f32x16 acc[2][2];
#pragma unroll
    for (int i = 0; i < 2; ++i)
#pragma unroll
      for (int jn = 0; jn < 2; ++jn)
#pragma unroll
        for (int r = 0; r < 16; ++r) acc[i][jn][r] = 0.f;
    u32x4 ra[4], rb[4];
#pragma unroll
    for (int i = 0; i < 4; ++i) {
      int c = tid + 256 * i, row = c >> 3, ch = c & 7;
      ra[i] = *(const u32x4*)(Ag + (size_t)row * lda + ch * 8);
      rb[i] = *(const u32x4*)(Bg + (size_t)row * K + ch * 8);
    }
#pragma unroll
    for (int i = 0; i < 4; ++i) {
      int c = tid + 256 * i, row = c >> 3, ch = c & 7;
      *(u32x4*)(sm + row * LDSROW + ch * 8) = ra[i];
      *(u32x4*)(sm + (128 + row) * LDSROW + ch * 8) = rb[i];
    }
    __syncthreads();
    for (int kt = 0; kt < nk; ++kt) {
      const bool more = (kt + 1 < nk);
      if (more) {
#pragma unroll
        for (int i = 0; i < 4; ++i) {
          int c = tid + 256 * i, row = c >> 3, ch = c & 7;
          ra[i] = *(const u32x4*)(Ag + (size_t)row * lda + (kt + 1) * 64 + ch * 8);
          rb[i] = *(const u32x4*)(Bg + (size_t)row * K + (kt + 1) * 64 + ch * 8);
        }
      }
      const bf16_t* As = sm + (kt & 1) * BUFE;
      const bf16_t* Bs = As + 128 * LDSROW;
#pragma unroll
      for (int ks = 0; ks < 4; ++ks) {
        bf16x8 a0 = *(const bf16x8*)(As + (wm * 64 + l31) * LDSROW + ks * 16 + 8 * h);
        bf16x8 a1 = *(const bf16x8*)(As + (wm * 64 + 32 + l31) * LDSROW + ks * 16 + 8 * h);
        bf16x8 b0 = *(const bf16x8*)(Bs + (wn * 64 + l31) * LDSROW + ks * 16 + 8 * h);
        bf16x8 b1 = *(const bf16x8*)(Bs + (wn * 64 + 32 + l31) * LDSROW + ks * 16 + 8 * h);
        acc[0][0] = mfma32(a0, b0, acc[0][0]);
        acc[0][1] = mfma32(a0, b1, acc[0][1]);
        acc[1][0] = mfma32(a1, b0, acc[1][0]);
        acc[1][1] = mfma32(a1, b1, acc[1][1]);
      }
      if (more) {
        bf16_t* dsm = sm + ((kt + 1) & 1) * BUFE;
#pragma unroll
        for (int i = 0; i < 4; ++i) {
          int c = tid + 256 * i, row = c >> 3, ch = c & 7;
          *(u32x4*)(dsm + row * LDSROW + ch * 8) = ra[i];
          *(u32x4*)(dsm + (128 + row) * LDSROW + ch * 8) = rb[i];
        }
      }
      __syncthreads();
    }
    gemm_epilogue<EPI>(p, acc, m0, n0, wm, wn, l31, h);
  }
}

template <int DQK, int NMAP, int DV, int KIND, bool PREFETCH>
DI void attn_unit(char* smem, const bf16_t* Qp, int ldq, const bf16_t* Kp, int ldk, const bf16_t* Vt, int ldv,
                                       int kt0, int kt1, const int* posq, const int* posk, float slope2, float sink2, int q0idx,
                                       float lam, const float* headg, float outscale, bf16_t* Op, int ldo) {
  constexpr int KROW = NMAP * DQK + 8, VROW = 72;
  constexpr int KBYTES = 64 * KROW * 2, VBYTES = DV * VROW * 2, BUFBYTES = KBYTES + VBYTES + 256;
  constexpr int CH = NMAP * DQK / 8, KCH = CH / 4, VCH = DV / 32;
  constexpr int NKS = DQK / 16, NDB = DV / 32;
  const int tid = opaque_tid(), lane = tid & 63, w = tid >> 6, l31 = lane & 31, h = lane >> 5;

  bf16x8 qf[NMAP][NKS];
  {
    const bf16_t* qrow = Qp + (size_t)(32 * w + l31) * ldq;
#pragma unroll
    for (int m = 0; m < NMAP; ++m)
#pragma unroll
      for (int ks = 0; ks < NKS; ++ks) qf[m][ks] = *(const bf16x8*)(qrow + m * DQK + ks * 16 + 8 * h);
  }
  float pq = 0.f;
  if (KIND == 0 || KIND == 2) pq = (float)posq[32 * w + l31];
  const int qidx = q0idx + 32 * w + l31;

  f32x16 O[NMAP][NDB];
  float mrun[NMAP], lrun[NMAP];
#pragma unroll
  for (int m = 0; m < NMAP; ++m) {
#pragma unroll
    for (int db = 0; db < NDB; ++db)
#pragma unroll
      for (int r = 0; r < 16; ++r) O[m][db][r] = 0.f;
    if (KIND == 2) { mrun[m] = sink2; lrun[m] = (h == 0) ? 1.f : 0.f; }
    else { mrun[m] = -1e30f; lrun[m] = 0.f; }
  }

  u32x4 kreg[KCH], vreg[VCH]; float pkreg = 0.f;
#define LOAD_REGS(kt_) do { \
    _Pragma("unroll") for (int i_ = 0; i_ < KCH; ++i_) { int c_ = tid + 256 * i_, row_ = c_ / CH, ch_ = c_ % CH; kreg[i_] = *(const u32x4*)(Kp + (size_t)((kt_) * 64 + row_) * ldk + ch_ * 8); } \
    _Pragma("unroll") for (int i_ = 0; i_ < VCH; ++i_) { int c_ = tid + 256 * i_, row_ = c_ >> 3, ch_ = c_ & 7; vreg[i_] = *(const u32x4*)(Vt + (size_t)row_ * ldv + (kt_) * 64 + ch_ * 8); } \
    if (KIND == 0 || KIND == 2) { pkreg = (float)posk[(kt_) * 64 + (tid & 63)]; } } while (0)
#define COPY_TILE(kt_) do { \
    bf16_t* Ks_ = (bf16_t*)smem; bf16_t* Vs_ = (bf16_t*)(smem + KBYTES); \
    _Pragma("unroll") for (int i0_ = 0; i0_ < KCH; i0_ += 4) { \
      u32x4 t_[4]; \
      _Pragma("unroll") for (int i_ = 0; i_ < 4; ++i_) if (i0_ + i_ < KCH) { int c_ = tid + 256 * (i0_ + i_), row_ = c_ / CH, ch_ = c_ % CH; t_[i_] = *(const u32x4*)(Kp + (size_t)((kt_) * 64 + row_) * ldk + ch_ * 8); } \
      _Pragma("unroll") for (int i_ = 0; i_ < 4; ++i_) if (i0_ + i_ < KCH) { int c_ = tid + 256 * (i0_ + i_), row_ = c_ / CH, ch_ = c_ % CH; *(u32x4*)(Ks_ + row_ * KROW + ch_ * 8) = t_[i_]; } \
      __builtin_amdgcn_sched_barrier(0); } \
    _Pragma("unroll") for (int i_ = 0; i_ < VCH; ++i_) { int c_ = tid + 256 * i_, row_ = c_ >> 3, ch_ = c_ & 7; u32x4 t_ = *(const u32x4*)(Vt + (size_t)row_ * ldv + (kt_) * 64 + ch_ * 8); *(u32x4*)(Vs_ + row_ * VROW + ch_ * 8) = t_; } \
    } while (0)
#define STORE_REGS(buf_) do { \
    char* base_ = smem + (buf_) * BUFBYTES; \
    bf16_t* Ks_ = (bf16_t*)base_; bf16_t* Vs_ = (bf16_t*)(base_ + KBYTES); float* Ps_ = (float*)(base_ + KBYTES + VBYTES); \
    _Pragma("unroll") for (int i_ = 0; i_ < KCH; ++i_) { int c_ = tid + 256 * i_, row_ = c_ / CH, ch_ = c_ % CH; *(u32x4*)(Ks_ + row_ * KROW + ch_ * 8) = kreg[i_]; } \
    _Pragma("unroll") for (int i_ = 0; i_ < VCH; ++i_) { int c_ = tid + 256 * i_, row_ = c_ >> 3, ch_ = c_ & 7; *(u32x4*)(Vs_ + row_ * VROW + ch_ * 8) = vreg[i_]; } \
    if (KIND == 0 || KIND == 2) { if (tid < 64) Ps_[tid] = pkreg; } } while (0)

  __syncthreads();
  if (PREFETCH) { LOAD_REGS(kt0); STORE_REGS(0); } else { COPY_TILE(kt0); }
  __syncthreads();

#pragma unroll 1
  for (int kt = kt0; kt < kt1; ++kt) {
    const int cur = PREFETCH ? ((kt - kt0) & 1) : 0;
    const bool more = (kt + 1 < kt1);
    if (PREFETCH && more) LOAD_REGS(kt + 1);
    {
      const char* base = smem + cur * BUFBYTES;
      const bf16_t* Ks = (const bf16_t*)base; const bf16_t* Vs = (const bf16_t*)(base + KBYTES); const float* Ps = (const float*)(base + KBYTES + VBYTES);
#pragma unroll
      for (int m = 0; m < NMAP; ++m) {
        f32x16 S[2];
#pragma unroll
        for (int mb = 0; mb < 2; ++mb)
#pragma unroll
          for (int r = 0; r < 16; ++r) S[mb][r] = 0.f;
#pragma unroll
        for (int ks = 0; ks < NKS; ++ks) {
          bf16x8 a0 = *(const bf16x8*)(Ks + (l31) * KROW + m * DQK + ks * 16 + 8 * h);
          bf16x8 a1 = *(const bf16x8*)(Ks + (32 + l31) * KROW + m * DQK + ks * 16 + 8 * h);
          S[0] = mfma32(a0, qf[m][ks], S[0]);
          S[1] = mfma32(a1, qf[m][ks], S[1]);
          if ((ks & 1) == 1) __builtin_amdgcn_sched_barrier(0);
        }
        if (KIND == 0 || KIND == 2) {
#pragma unroll
          for (int mb = 0; mb < 2; ++mb)
#pragma unroll
            for (int g = 0; g < 4; ++g) {
              float4 pk4 = *(const float4*)(Ps + mb * 32 + 8 * g + 4 * h);
#pragma unroll
              for (int i = 0; i < 4; ++i) {
                const float pkv = (i == 0) ? pk4.x : (i == 1) ? pk4.y : (i == 2) ? pk4.z : pk4.w;
                float s = S[mb][4 * g + i] - slope2 * fabsf(pq - pkv);
                if (KIND == 2) {
                  int kidx = kt * 64 + mb * 32 + 8 * g + 4 * h + i;
                  int dd = kidx - qidx; dd = dd < 0 ? -dd : dd;
                  if (dd > 128) s = -1e30f;
                }
                S[mb][4 * g + i] = s;
              }
            }
        }
        __builtin_amdgcn_sched_barrier(0);
        float mx = S[0][0];
#pragma unroll
        for (int mb = 0; mb < 2; ++mb)
#pragma unroll
          for (int r = 0; r < 16; ++r) mx = fmaxf(mx, S[mb][r]);
        mx = fmaxf(mx, __shfl_xor(mx, 32));
        const float mnew = fmaxf(mrun[m], mx);
        const float alpha = fexp2(mrun[m] - mnew);
        mrun[m] = mnew;
        float rs = 0.f;
#pragma unroll
        for (int mb = 0; mb < 2; ++mb)
#pragma unroll
          for (int r = 0; r < 16; ++r) { float pv = fexp2(S[mb][r] - mnew); S[mb][r] = pv; rs += pv; }
        lrun[m] = lrun[m] * alpha + rs;
#pragma unroll
        for (int db = 0; db < NDB; ++db)
#pragma unroll
          for (int r = 0; r < 16; ++r) O[m][db][r] *= alpha;
        bf16x8 pf[4];
#pragma unroll
        for (int mb = 0; mb < 2; ++mb)
#pragma unroll
          for (int s = 0; s < 2; ++s) {
            u32x4 u;
            u[0] = pack2(S[mb][8 * s + 0], S[mb][8 * s + 1]); u[1] = pack2(S[mb][8 * s + 2], S[mb][8 * s + 3]);
            u[2] = pack2(S[mb][8 * s + 4], S[mb][8 * s + 5]); u[3] = pack2(S[mb][8 * s + 6], S[mb][8 * s + 7]);
            pf[mb * 2 + s] = __builtin_bit_cast(bf16x8, u);
          }
#pragma unroll
        for (int db = 0; db < NDB; ++db) {
#pragma unroll
          for (int kk = 0; kk < 4; ++kk) {
            bf16x8 a = *(const bf16x8*)(Vs + (db * 32 + l31) * VROW + kk * 16 + 8 * h);
            O[m][db] = mfma32(a, pf[kk], O[m][db]);
          }
          __builtin_amdgcn_sched_barrier(0);
        }
      }
    }
    if (PREFETCH) {
      if (more) STORE_REGS(cur ^ 1);
      __syncthreads();
    } else {
      __syncthreads();
      if (more) { COPY_TILE(kt + 1); __syncthreads(); }
    }
  }

  float inv[NMAP];
#pragma unroll
  for (int m = 0; m < NMAP; ++m) { float lt = lrun[m] + __shfl_xor(lrun[m], 32); inv[m] = 1.f / lt; }
  bf16_t* orow = Op + (size_t)(32 * w + l31) * ldo;
  if (KIND == 0) {
    float ss = 0.f;
#pragma unroll
    for (int db = 0; db < NDB; ++db)
#pragma unroll
      for (int r = 0; r < 16; ++r) {
        float o = O[0][db][r] * inv[0] - lam * (O[NMAP - 1][db][r] * inv[NMAP - 1]);
        O[0][db][r] = o; ss += o * o;
      }
    ss += __shfl_xor(ss, 32);
    const float rs = rsqrtf(ss * (1.f / 64.f) + EPSN) * outscale;
#pragma unroll
    for (int db = 0; db < NDB; ++db)
#pragma unroll
      for (int g = 0; g < 4; ++g) {
        int dv = db * 32 + 8 * g + 4 * h;
        float4 gg = *(const float4*)(headg + dv);
        uint2 u; u.x = pack2(O[0][db][4 * g] * rs * gg.x, O[0][db][4 * g + 1] * rs * gg.y);
        u.y = pack2(O[0][db][4 * g + 2] * rs * gg.z, O[0][db][4 * g + 3] * rs * gg.w);
        *(uint2*)(orow + dv) = u;
      }
  } else {
#pragma unroll
    for (int db = 0; db < NDB; ++db)
#pragma unroll
      for (int g = 0; g < 4; ++g) {
        int dv = db * 32 + 8 * g + 4 * h;
        uint2 u; u.x = pack2(O[0][db][4 * g] * inv[0], O[0][db][4 * g + 1] * inv[0]);
        u.y = pack2(O[0][db][4 * g + 2] * inv[0], O[0][db][4 * g + 3] * inv[0]);
        *(uint2*)(orow + dv) = u;
      }
  }
}

#undef LOAD_REGS
#undef COPY_TILE
#undef STORE_REGS
DI void phase_rows_init_or_res3(const Params& p, int l, bool init, char* smem) {
  const int tid_ = opaque_tid(); const int lane = tid_ & 63, w = tid_ >> 6;
  bf16_t* H = (bf16_t*)(p.ws + OFF_H);
  const float* Y = (const float*)(p.ws + OFF_Y);
  const int nl = init ? 0 : l + 1;
  for (int row = blockIdx.x * 4 + w; row < NTOK; row += gridDim.x * 4) {
    size_t ro = (size_t)row * 1024;
    if (init) row_op<false, true>(p.x_in + ro, nullptr, nullptr, nullptr, p.g_mix_pre, H + ro, lane);
    else if (l < DEPTH - 1) row_op<true, true>(p.xres + ro, Y + ro, p.g_ffn_post + l * 1024, p.xres + ro, p.g_mix_pre + (l + 1) * 1024, H + ro, lane);
    else row_op<true, false>(p.xres + ro, Y + ro, p.g_ffn_post + l * 1024, p.xres + ro, nullptr, nullptr, lane);
  }
  if (nl < DEPTH) {
    bf16_t* MEMN = (bf16_t*)(p.ws + OFF_SM);
    for (int row = blockIdx.x * 4 + w; row < 512; row += gridDim.x * 4) {
      size_t ro = (size_t)row * 1024;
      row_op<false, true>(p.mem + ro, nullptr, nullptr, nullptr, p.g_x_mem + nl * 1024, MEMN + ro, lane);
    }
    convert_weights(p, nl, smem);
  }
}

DI void phase_rows_res(const Params& p, const float* xsrc, const float* gpost, const float* gnext) {
  const int tid_ = opaque_tid(); const int lane = tid_ & 63, w = tid_ >> 6;
  bf16_t* H = (bf16_t*)(p.ws + OFF_H);
  const float* Y = (const float*)(p.ws + OFF_Y);
  for (int row = blockIdx.x * 4 + w; row < NTOK; row += gridDim.x * 4) {
    size_t ro = (size_t)row * 1024;
    row_op<true, true>(xsrc + ro, Y + ro, gpost, p.xres + ro, gnext, H + ro, lane);
  }
}

DI void phase_rows_mla(const Params& p, int l) {
  const int tid_ = opaque_tid(); const int lane = tid_ & 63, w = tid_ >> 6;
  const bf16_t* PROJ = (const bf16_t*)(p.ws + OFF_BIG);
  bf16_t* MLAN = (bf16_t*)(p.ws + OFF_Y);
  bf16_t* KB = (bf16_t*)(p.ws + OFF_Y + 48 * MiB);
  const float* gq = p.mla_q_norm_g + l * 256;
  const float* gkv = p.mla_kv_norm_g + l * 128;
  for (int row = blockIdx.x * 4 + w; row < NTOK; row += gridDim.x * 4) {
    const bf16_t* pr = PROJ + (size_t)row * 2048;
    uint2 cq = *(const uint2*)(pr + 768 + lane * 4);
    uint32_t ckv = *(const uint32_t*)(pr + 1024 + lane * 2);
    float q0 = frombf(cq.x & 0xffffu), q1 = frombf(cq.x >> 16), q2 = frombf(cq.y & 0xffffu), q3 = frombf(cq.y >> 16);
    float k0 = frombf(ckv & 0xffffu), k1 = frombf(ckv >> 16);
    float ssq = wave_sum(q0 * q0 + q1 * q1 + q2 * q2 + q3 * q3);
    float ssk = wave_sum(k0 * k0 + k1 * k1);
    float rq = rsqrtf(ssq * (1.f / 256.f) + EPSN), rk = rsqrtf(ssk * (1.f / 128.f) + EPSN);
    float4 g4 = *(const float4*)(gq + lane * 4);
    float2 g2 = *(const float2*)(gkv + lane * 2);
    uint2 u; u.x = pack2(q0 * rq * g4.x, q1 * rq * g4.y); u.y = pack2(q2 * rq * g4.z, q3 * rq * g4.w);
    *(uint2*)(MLAN + (size_t)row * 384 + lane * 4) = u;
    *(uint32_t*)(MLAN + (size_t)row * 384 + 256 + lane * 2) = pack2(k0 * rk * g2.x, k1 * rk * g2.y);
    if (lane < 16) {
      float x1 = frombf(pr[1152 + lane]), x2 = frombf(pr[1152 + 16 + lane]);
      float ang = (float)p.pos[row] * rope_inv(lane);
      float s, c; sincos_red(ang, s, c);
      bf16_t o1 = tobf(x1 * c - x2 * s), o2 = tobf(x1 * s + x2 * c);
      bf16_t* kb = KB + (size_t)row * 384;
#pragma unroll
      for (int hd = 0; hd < 4; ++hd) { kb[hd * 96 + 64 + lane] = o1; kb[hd * 96 + 80 + lane] = o2; }
    }
  }
}

DI void phase_attn(const Params& p, int l, char* smem) {
  const int xcd = blockIdx.x & 7, slot = blockIdx.x >> 3, nslots = gridDim.x >> 3;
  const bf16_t* PROJ = (const bf16_t*)(p.ws + OFF_BIG);
  bf16_t* MIX = (bf16_t*)(p.ws + OFF_BIG + 128 * MiB);
  const bf16_t* QB = (const bf16_t*)(p.ws + OFF_Y + 24 * MiB);
  const bf16_t* KB = (const bf16_t*)(p.ws + OFF_Y + 48 * MiB);
  const bf16_t* VtA = (const bf16_t*)(p.ws + OFF_Y + 72 * MiB);
  const bf16_t* VtB = (const bf16_t*)(p.ws + OFF_Y + 88 * MiB);
  const bf16_t* VtC = (const bf16_t*)(p.ws + OFF_Y + 104 * MiB);
  const float* lp = p.diff_lambda + l * 128;
  float d0 = 0.f, d1 = 0.f;
  for (int i = 0; i < 32; ++i) { d0 += lp[i] * lp[32 + i]; d1 += lp[64 + i] * lp[96 + i]; }
  const float lam_init = 0.8f - 0.6f * expf(-0.3f * (float)l);
  const float lam = expf(d0) - expf(d1) + lam_init;
  const int b = xcd >> 2, head = xcd & 3;
  if (ATT_SEL & 1) {
    const float slope2 = exp2f(-8.f * (float)(9 + head) / 12.f) * LOG2E;
    for (int qb = slot; qb < 128; qb += nslots) {
      const size_t t0 = (size_t)b * SEQ + qb * 128;
      attn_unit<32, 2, 64, 0, true>(smem, PROJ + t0 * 2048 + head * 64, 2048, PROJ + (size_t)b * SEQ * 2048 + 256 + head * 64, 2048,
                                    VtA + (size_t)(b * 4 + head) * 64 * SEQ, SEQ, 0, SEQ / 64, p.pos + t0, p.pos + (size_t)b * SEQ, slope2, 0.f, qb * 128,
                                    lam, p.diff_head_g + l * 64, 1.f - lam_init, MIX + t0 * 1024 + head * 64, 1024);
    }
  }
  if (ATT_SEL & 2) for (int qb = slot; qb < 128; qb += nslots) {
    const size_t t0 = (size_t)b * SEQ + qb * 128;
    attn_unit<96, 1, 64, 1, true>(smem, QB + t0 * 384 + head * 96, 384, KB + (size_t)b * SEQ * 384 + head * 96, 384,
                                  VtB + (size_t)(b * 4 + head) * 64 * SEQ, SEQ, 0, SEQ / 64, nullptr, nullptr, 0.f, 0.f, qb * 128,
                                  0.f, nullptr, 1.f, MIX + t0 * 1024 + 256 + head * 64, 1024);
  }
  if (ATT_SEL & 4) for (int j = slot; j < 256; j += nslots) {
    const int hq = (xcd & 3) * 2 + (j >> 7), qb = j & 127, kvh = hq >> 2;
    const size_t t0 = (size_t)b * SEQ + qb * 128;
    const float slope2 = exp2f(-8.f * (float)(hq + 1) / 12.f) * LOG2E;
    const float sink2 = p.swa_sinks[l * 8 + hq] * LOG2E;
    int kt0 = 2 * qb - 2, kt1 = 2 * qb + 4;
    if (kt0 < 0) kt0 = 0;
    if (kt1 > SEQ / 64) kt1 = SEQ / 64;
    attn_unit<64, 1, 64, 2, true>(smem, PROJ + t0 * 2048 + 1184 + hq * 64, 2048, PROJ + (size_t)b * SEQ * 2048 + 1696 + kvh * 64, 2048,
                                  VtC + (size_t)(b * 2 + kvh) * 64 * SEQ, SEQ, kt0, kt1, p.pos + t0, p.pos + (size_t)b * SEQ, slope2, sink2, qb * 128,
                                  0.f, nullptr, 1.f, MIX + t0 * 1024 + 512 + hq * 64, 1024);
  }
}

DI void phase_xattn(const Params& p, char* smem) {
  const int xcd = blockIdx.x & 7, slot = blockIdx.x >> 3, nslots = gridDim.x >> 3;
  const bf16_t* QX = (const bf16_t*)(p.ws + OFF_BIG);
  bf16_t* OX = (bf16_t*)(p.ws + OFF_BIG + 64 * MiB);
  const bf16_t* KX = (const bf16_t*)(p.ws + OFF_SM + 1 * MiB);
  const bf16_t* VtX = (const bf16_t*)(p.ws + OFF_SM + 2 * MiB);
  const int b = xcd >> 2, head = xcd & 3;
  for (int j = slot; j < 512; j += nslots) {
    const int dvh = j >> 7, qb = j & 127;
    const size_t t0 = (size_t)b * SEQ + qb * 128;
    attn_unit<256, 1, 64, 3, false>(smem, QX + t0 * 1024 + head * 256, 1024, KX + (size_t)b * 256 * 1024 + head * 256, 1024,
                                     VtX + ((size_t)(b * 4 + head) * 256 + dvh * 64) * 256, 256, 0, 4, nullptr, nullptr, 0.f, 0.f, 0,
                                     0.f, nullptr, 1.f, OX + t0 * 1024 + head * 256 + dvh * 64, 1024);
  }
}

DI void run_phase(const Params& p, int ph, char* smem) {
  bf16_t* W = (bf16_t*)(p.ws + OFF_W);
  bf16_t* H = (bf16_t*)(p.ws + OFF_H);
  bf16_t* BIG = (bf16_t*)(p.ws + OFF_BIG);
  if (ph == 0) { phase_rows_init_or_res3(p, 0, true, smem); return; }
  const int l = (ph - 1) / 13, s = (ph - 1) % 13;
  switch (s) {
    case 0:
      gemm_phase<EPI_PROJ>(p, smem, H, 1024, W + WO_IN, 1024, 256, 16, 1);
      gemm_phase<EPI_XKV>(p, smem, (const bf16_t*)(p.ws + OFF_SM), 1024, W + WO_XKV, 1024, 4, 16, 0);
      break;
    case 1: phase_rows_mla(p, l); break;
    case 2:
      gemm_phase<EPI_QUP>(p, smem, (const bf16_t*)(p.ws + OFF_Y), 384, W + WO_QUP, 256, 256, 3, 1);
      gemm_phase<EPI_KVUP>(p, smem, (const bf16_t*)(p.ws + OFF_Y) + 256, 384, W + WO_KVUP, 128, 256, 4, 1);
      break;
    case 3: phase_attn(p, l, smem); break;
    case 4: gemm_phase<EPI_F32>(p, smem, BIG + (size_t)64 * MiB, 1024, W + WO_OUT, 1024, 256, 8, 1); break;
    case 5: phase_rows_res(p, l == 0 ? p.x_in : p.xres, p.g_mix_post + l * 1024, p.g_x_pre + l * 1024); break;
    case 6: gemm_phase<EPI_XQ>(p, smem, H, 1024, W + WO_XQ, 1024, 256, 8, 1); break;
    case 7: phase_xattn(p, smem); break;
    case 8: gemm_phase<EPI_F32>(p, smem, BIG + (size_t)32 * MiB, 1024, W + WO_XO, 1024, 256, 8, 1); break;
    case 9: phase_rows_res(p, p.xres, p.g_x_post + l * 1024, p.g_ffn_pre + l * 1024); break;
    case 10: gemm_phase<EPI_SWIGLU>(p, smem, H, 1024, W + WO_FI, 1024, 256, 44, 1); break;
    case 11: gemm_phase<EPI_F32>(p, smem, BIG, DFF, W + WO_FO, DFF, 256, 8, 1); break;
    case 12: phase_rows_init_or_res3(p, l, false, smem); break;
  }
}

constexpr int NPHASES = 1 + 13 * DEPTH;

__global__ void __launch_bounds__(NTHREADS, 2) fwd_megakernel(Params p) {
  __shared__ __attribute__((aligned(16))) char smem[SMEM_BYTES];
  cg::grid_group grid = cg::this_grid();
  for (int ph = p.phase_begin; ph < p.phase_end; ++ph) {
    run_phase(p, ph, smem);
    if (ph + 1 < p.phase_end) grid.sync();
  }
}

extern "C" void kernel_launch(void* const* d_in, const int* in_sizes, int n_in, void* d_out, int out_size, void* d_ws, size_t ws_size,
                              hipStream_t stream) {
  static int grid_blocks = 0;
  if (!grid_blocks) {
    int dev = 0, cus = 0, per_cu = 0;
    hipGetDevice(&dev);
    hipDeviceGetAttribute(&cus, hipDeviceAttributeMultiprocessorCount, dev);
    hipOccupancyMaxActiveBlocksPerMultiprocessor(&per_cu, fwd_megakernel, NTHREADS, 0);
    if (per_cu > 2) per_cu = 2;
    if (per_cu < 1) per_cu = 1;
    grid_blocks = cus * per_cu;
    grid_blocks &= ~7;
  }
  Params p{};
  p.x_in = (const float*)d_in[0]; p.mem = (const float*)d_in[1]; p.pos = (const int*)d_in[2];
  p.g_mix_pre = (const float*)d_in[3]; p.g_mix_post = (const float*)d_in[4]; p.w_in = (const float*)d_in[5];
  p.diff_lambda = (const float*)d_in[6]; p.diff_head_g = (const float*)d_in[7]; p.mla_q_norm_g = (const float*)d_in[8];
  p.mla_w_q_up = (const float*)d_in[9]; p.mla_kv_norm_g = (const float*)d_in[10]; p.mla_w_kv_up = (const float*)d_in[11];
  p.swa_sinks = (const float*)d_in[12]; p.w_out = (const float*)d_in[13]; p.g_x_pre = (const float*)d_in[14];
  p.g_x_mem = (const float*)d_in[15]; p.g_x_post = (const float*)d_in[16]; p.w_xq = (const float*)d_in[17];
  p.w_xkv = (const float*)d_in[18]; p.w_xo = (const float*)d_in[19]; p.g_ffn_pre = (const float*)d_in[20];
  p.g_ffn_post = (const float*)d_in[21]; p.w_ffn_in = (const float*)d_in[22]; p.w_ffn_out = (const float*)d_in[23];
  p.xres = (float*)d_out; p.ws = (char*)d_ws;
#if SINGLE_LAUNCH
  p.phase_begin = 0; p.phase_end = NPHASES;
  void* args[] = {&p};
  hipError_t e = hipLaunchCooperativeKernel((void*)fwd_megakernel, dim3(grid_blocks), dim3(NTHREADS), args, 0, stream);
  if (e != hipSuccess) fprintf(stderr, "cooperative launch failed: %s (grid %d)\n", hipGetErrorString(e), grid_blocks);
#else
  for (int ph = 0; ph < NPHASES; ++ph) {
    p.phase_begin = ph; p.phase_end = ph + 1;
    fwd_megakernel<<<dim3(grid_blocks), dim3(NTHREADS), 0, stream>>>(p);
  }
#endif
}
```

```cpp
#include <hip/hip_runtime.h>
#include <hip/hip_cooperative_groups.h>
#include <stdint.h>
#include <stdio.h>
namespace cg = cooperative_groups;

#ifndef SINGLE_LAUNCH
#define SINGLE_LAUNCH 1
#endif

#ifndef PROBE_DUP
#define PROBE_DUP 0
#endif
#ifndef ATT_SEL
#define ATT_SEL 7
#endif
#define DI __device__ __forceinline__
typedef unsigned short bf16_t;
typedef __attribute__((ext_vector_type(8))) short bf16x8;
typedef __attribute__((ext_vector_type(16))) float f32x16;
typedef __bf16 bf16x2_t __attribute__((ext_vector_type(2)));
typedef float f32x2_t __attribute__((ext_vector_type(2)));
typedef uint32_t u32x4 __attribute__((ext_vector_type(4)));
typedef uint32_t u32x2 __attribute__((ext_vector_type(2)));
typedef float f32x4 __attribute__((ext_vector_type(4)));

constexpr int SEQ = 16384, NTOK = 32768, DM = 1024, DFF = 2816, DIN = 1952, DEPTH = 4;
constexpr float LOG2E = 1.4426950408889634f;
constexpr float EPSN = 1e-6f;
constexpr int NTHREADS = 256;
constexpr int SMEM_BYTES = 73728;

constexpr size_t MiB = 1ull << 20;
constexpr size_t OFF_W = 0, OFF_H = 33 * MiB, OFF_Y = 97 * MiB, OFF_BIG = 225 * MiB, OFF_SM = 417 * MiB, OFF_BAR = 421 * MiB;
constexpr size_t WO_IN = 0;
constexpr size_t WO_QUP = WO_IN + 2048 * 1024;
constexpr size_t WO_KVUP = WO_QUP + 384 * 256;
constexpr size_t WO_OUT = WO_KVUP + 512 * 128;
constexpr size_t WO_XQ = WO_OUT + 1024 * 1024;
constexpr size_t WO_XKV = WO_XQ + 1024 * 1024;
constexpr size_t WO_XO = WO_XKV + 2048 * 1024;
constexpr size_t WO_FI = WO_XO + 1024 * 1024;
constexpr size_t WO_FO = WO_FI + 5632 * 1024;

struct Params {
  const float* x_in; const float* mem; const int* pos;
  const float* g_mix_pre; const float* g_mix_post; const float* w_in; const float* diff_lambda; const float* diff_head_g;
  const float* mla_q_norm_g; const float* mla_w_q_up; const float* mla_kv_norm_g; const float* mla_w_kv_up;
  const float* swa_sinks; const float* w_out; const float* g_x_pre; const float* g_x_mem; const float* g_x_post;
  const float* w_xq; const float* w_xkv; const float* w_xo; const float* g_ffn_pre; const float* g_ffn_post;
  const float* w_ffn_in; const float* w_ffn_out;
  float* xres;
  char* ws;
  int phase_begin, phase_end, pad0, pad1;
};

DI uint32_t pack2(float a, float b) { f32x2_t v = {a, b}; bf16x2_t r = __builtin_convertvector(v, bf16x2_t); return __builtin_bit_cast(uint32_t, r); }
DI bf16_t tobf(float a) { return (bf16_t)(pack2(a, 0.f) & 0xffffu); }
DI float frombf(uint32_t v) { return __uint_as_float(v << 16); }
DI f32x16 mfma32(bf16x8 a, bf16x8 b, f32x16 c) { return __builtin_amdgcn_mfma_f32_32x32x16_bf16(a, b, c, 0, 0, 0); }
DI int opaque_tid() { int t = threadIdx.x; asm volatile("" : "+v"(t)); return t; }
DI float fexp2(float x) { return __builtin_amdgcn_exp2f(x); }
DI float wave_sum(float v) {
#pragma unroll
  for (int o = 32; o >= 1; o >>= 1) v += __shfl_xor(v, o);
  return v;
}
DI float half_max(float v) {
  auto r = __builtin_amdgcn_permlane32_swap(__float_as_uint(v), __float_as_uint(v), false, false);
  return fmaxf(__uint_as_float(r[0]), __uint_as_float(r[1]));
}
DI float rope_inv(int i) { return exp2f(-(float)i * 0.8304820237218406f); }
DI void sincos_red(float ang, float& s, float& c) {
  double a = (double)ang;
  double k = rint(a * 0.15915494309189535);
  float r = (float)(a - k * 6.283185307179586);
  s = sinf(r); c = cosf(r);
}
DI void store_vt(bf16_t* rowbase, int tok32, int g, int h, float v0, float v1, float v2, float v3) {
  int pos = tok32 + 16 * (g >> 1) + 8 * h + 4 * (g & 1);
  uint2 u; u.x = pack2(v0, v1); u.y = pack2(v2, v3);
  *(uint2*)(rowbase + pos) = u;
}


#define XB_TMO      128
#define XB_XCNT(j)  (256  + 64 * (j))
#define XB_XSUB(j)  (1280 + 64 * (j))
#define XB_XGEN(j)  (2304 + 64 * (j))
#define XB_TOP      3328
#define XB_TOPGEN   3392
#define XCD_BAR_WORDS 3456
#define XB_SPIN_CAP (1u << 22)
#define LAS __attribute__((address_space(3)))
DI unsigned xb_ld(unsigned* p)              { return __hip_atomic_load(p, __ATOMIC_RELAXED, __HIP_MEMORY_SCOPE_AGENT); }
DI unsigned xb_add(unsigned* p, unsigned v) { return __hip_atomic_fetch_add(p, v, __ATOMIC_RELAXED, __HIP_MEMORY_SCOPE_AGENT); }
DI unsigned xb_xcc_id() { return (unsigned)__builtin_amdgcn_s_getreg((3 << 11) | 20) & 0xFu; }
#define XB_SPIN(cond, bar) do { unsigned _sp = 0; while (cond) { __builtin_amdgcn_s_sleep(1); \
    if ((++_sp & 255u) == 0u) { if (xb_ld(&(bar)[XB_TMO])) break; if (_sp > XB_SPIN_CAP) { atomicAdd(&(bar)[XB_TMO], 1u); break; } } } } while (0)
struct XcdBarrier { unsigned* bar; unsigned x; volatile LAS unsigned* st; };
DI XcdBarrier xcd_barrier_post(unsigned* bar, volatile LAS unsigned* st) {
  XcdBarrier b; b.bar = bar; b.x = xb_xcc_id(); b.st = st;
  if (threadIdx.x == 0) (void)xb_add(&bar[XB_XCNT(b.x)], 1u);
  return b;
}
DI void xcd_barrier_complete(unsigned* bar, unsigned x, unsigned& nloc, unsigned& nx) {
  const unsigned G = gridDim.x * gridDim.y * gridDim.z;
  unsigned sum, cnt, mine, sp = 0u;
  for (;;) {
    sum = 0u; cnt = 0u; mine = 0u;
#pragma unroll
    for (unsigned j = 0; j < 16; ++j) { const unsigned c = xb_ld(&bar[XB_XCNT(j)]); sum += c; cnt += (c > 0u) ? 1u : 0u; mine = (j == x) ? c : mine; }
    if (sum == G) break;
    __builtin_amdgcn_s_sleep(1);
    if ((++sp & 255u) == 0u) { if (xb_ld(&bar[XB_TMO])) break; if (sp > XB_SPIN_CAP) { atomicAdd(&bar[XB_TMO], 1u); break; } }
  }
  nloc = mine > 0u ? mine : 1u; nx = cnt > 0u ? cnt : 1u;
}
DI void xcd_barrier(const XcdBarrier& b) {
  asm volatile("s_waitcnt vmcnt(0)" ::: "memory");
  __syncthreads();
  if (threadIdx.x == 0) {
    unsigned* bar = b.bar;
    __builtin_amdgcn_s_waitcnt(0);
    unsigned nloc = b.st[0], nx = b.st[1];
    if (nloc == 0u) { xcd_barrier_complete(bar, b.x, nloc, nx); b.st[0] = nloc; b.st[1] = nx; }
    const unsigned old = xb_add(&bar[XB_XSUB(b.x)], 1u);
    const unsigned gen = old / nloc;
    if (old + 1u == (gen + 1u) * nloc) {
      __builtin_amdgcn_fence(__ATOMIC_RELEASE, "agent");
      asm volatile("s_waitcnt vmcnt(0)" ::: "memory");
      const unsigned og = xb_add(&bar[XB_TOP], 1u);
      const unsigned tg = og / nx;
      if (og + 1u == (tg + 1u) * nx) xb_add(&bar[XB_TOPGEN], 1u);
      else XB_SPIN(xb_ld(&bar[XB_TOPGEN]) == tg, bar);
      __builtin_amdgcn_fence(__ATOMIC_ACQUIRE, "agent");
      xb_add(&bar[XB_XGEN(b.x)], 1u);
      asm volatile("s_waitcnt vmcnt(0)" ::: "memory");
    } else {
      XB_SPIN(xb_ld(&bar[XB_XGEN(b.x)]) == gen, bar);
      __builtin_amdgcn_fence(__ATOMIC_ACQUIRE, "agent");
      asm volatile("s_waitcnt vmcnt(0)" ::: "memory");
    }
  }
  __syncthreads();
}

DI void convert_weights(const Params& p, int l, char* smem) {
  const int tid = opaque_tid();
  bf16_t* W = (bf16_t*)(p.ws + OFF_W);
  float* tile = (float*)smem;
  for (int t = blockIdx.x; t < 7840; t += gridDim.x) {
    const float* src; int K, N, lt, mode = 0; bf16_t* dst;
    if (t < 976)       { src = p.w_in + (size_t)l * 1024 * 1952;      K = 1024; N = 1952; dst = W + WO_IN;   lt = t; }
    else if (t < 1024) { src = p.mla_w_q_up + (size_t)l * 256 * 384;  K = 256;  N = 384;  dst = W + WO_QUP;  lt = t - 976; }
    else if (t < 1056) { src = p.mla_w_kv_up + (size_t)l * 128 * 512; K = 128;  N = 512;  dst = W + WO_KVUP; lt = t - 1024; }
    else if (t < 1568) { src = p.w_out + (size_t)l * 1024 * 1024;     K = 1024; N = 1024; dst = W + WO_OUT;  lt = t - 1056; }
    else if (t < 2080) { src = p.w_xq + (size_t)l * 1024 * 1024;      K = 1024; N = 1024; dst = W + WO_XQ;   lt = t - 1568; }
    else if (t < 3104) { src = p.w_xkv + (size_t)l * 1024 * 2048;     K = 1024; N = 2048; dst = W + WO_XKV;  lt = t - 2080; }
    else if (t < 3616) { src = p.w_xo + (size_t)l * 1024 * 1024;      K = 1024; N = 1024; dst = W + WO_XO;   lt = t - 3104; }
    else if (t < 6432) { src = p.w_ffn_in + (size_t)l * 1024 * 5632;  K = 1024; N = 5632; dst = W + WO_FI;   lt = t - 3616; mode = 1; }
    else               { src = p.w_ffn_out + (size_t)l * 2816 * 1024; K = 2816; N = 1024; dst = W + WO_FO;   lt = t - 6432; }
    const int nNt = N >> 5;
    const int k0 = (lt / nNt) * 64, n0 = (lt % nNt) * 32;
#pragma unroll
    for (int it = 0; it < 2; ++it) {
      const int c = tid + 256 * it, i = c >> 3, j4 = (c & 7) * 4;
      const float4 v = *(const float4*)(src + (size_t)(k0 + i) * N + n0 + j4);
      tile[i * 33 + j4] = v.x; tile[i * 33 + j4 + 1] = v.y; tile[i * 33 + j4 + 2] = v.z; tile[i * 33 + j4 + 3] = v.w;
    }
    __syncthreads();
    {
      const int jn = tid & 31, kg = (tid >> 5) * 8;
      u32x4 o;
      o[0] = pack2(tile[(kg + 0) * 33 + jn], tile[(kg + 1) * 33 + jn]);
      o[1] = pack2(tile[(kg + 2) * 33 + jn], tile[(kg + 3) * 33 + jn]);
      o[2] = pack2(tile[(kg + 4) * 33 + jn], tile[(kg + 5) * 33 + jn]);
      o[3] = pack2(tile[(kg + 6) * 33 + jn], tile[(kg + 7) * 33 + jn]);
      int n = n0 + jn, drow = n;
      if (mode == 1) drow = (n < DFF) ? ((n >> 5) * 64 + (n & 31)) : ((((n - DFF) >> 5) * 64) + 32 + ((n - DFF) & 31));
      *(u32x4*)(dst + (size_t)drow * K + k0 + kg) = o;
    }
    __syncthreads();
  }
  uint32_t* padp = (uint32_t*)(W + WO_IN + (size_t)1952 * 1024);
  for (int i = blockIdx.x * NTHREADS + tid; i < 49152; i += gridDim.x * NTHREADS) padp[i] = 0u;
}

template <bool RES, bool NORM2>
DI void row_op(const float* xsrc, const bf16_t* Yrow, const float* gpost, float* xdst, const float* gnext, bf16_t* Hout, int lane) {
  float4 xv[4];
#pragma unroll
  for (int j = 0; j < 4; ++j) { const f32x4 t_ = __builtin_nontemporal_load((const f32x4*)(xsrc + j * 256 + lane * 4)); xv[j].x = t_[0]; xv[j].y = t_[1]; xv[j].z = t_[2]; xv[j].w = t_[3]; }
  if (RES) {
    float4 yv[4]; float ss = 0.f;
#pragma unroll
    for (int j = 0; j < 4; ++j) {
      const u32x2 yt_ = __builtin_nontemporal_load((const u32x2*)(Yrow + j * 256 + lane * 4)); uint2 yu; yu.x = yt_[0]; yu.y = yt_[1];
      yv[j].x = frombf(yu.x & 0xffffu); yv[j].y = frombf(yu.x >> 16); yv[j].z = frombf(yu.y & 0xffffu); yv[j].w = frombf(yu.y >> 16);
      ss += yv[j].x * yv[j].x + yv[j].y * yv[j].y + yv[j].z * yv[j].z + yv[j].w * yv[j].w;
    }
    ss = wave_sum(ss);
    float rs = rsqrtf(ss * (1.f / 1024.f) + EPSN);
#pragma unroll
    for (int j = 0; j < 4; ++j) {
      float4 g = *(const float4*)(gpost + j * 256 + lane * 4);
      xv[j].x += yv[j].x * rs * g.x; xv[j].y += yv[j].y * rs * g.y; xv[j].z += yv[j].z * rs * g.z; xv[j].w += yv[j].w * rs * g.w;
      { f32x4 t_; t_[0] = xv[j].x; t_[1] = xv[j].y; t_[2] = xv[j].z; t_[3] = xv[j].w; __builtin_nontemporal_store(t_, (f32x4*)(xdst + j * 256 + lane * 4)); }
    }
  }
  if (NORM2) {
    float ss = 0.f;
#pragma unroll
    for (int j = 0; j < 4; ++j) ss += xv[j].x * xv[j].x + xv[j].y * xv[j].y + xv[j].z * xv[j].z + xv[j].w * xv[j].w;
    ss = wave_sum(ss);
    float rs = rsqrtf(ss * (1.f / 1024.f) + EPSN);
#pragma unroll
    for (int j = 0; j < 4; ++j) {
      float4 g = *(const float4*)(gnext + j * 256 + lane * 4);
      uint2 u; u.x = pack2(xv[j].x * rs * g.x, xv[j].y * rs * g.y); u.y = pack2(xv[j].z * rs * g.z, xv[j].w * rs * g.w);
      *(uint2*)(Hout + j * 256 + lane * 4) = u;
    }
  }
}

enum { EPI_F32 = 0, EPI_PROJ, EPI_XKV, EPI_QUP, EPI_KVUP, EPI_XQ, EPI_SWIGLU };

template <int EPI, int NB>
DI void gemm_epilogue(const Params& p, const f32x16 (&acc)[2][NB], int m0, int n0, int wm, int wn, int l31, int h) {
  bf16_t* PROJ = (bf16_t*)(p.ws + OFF_BIG);
#pragma unroll
  for (int i = 0; i < 2; ++i) {
    const int rb = m0 + wm * 64 + i * 32;
#pragma unroll
    for (int jn = 0; jn < NB; ++jn) {
      const int cb = n0 + wn * (32 * NB) + jn * 32;
      const int col = cb + l31;
      if (EPI == EPI_F32) {
        bf16_t* Y = (bf16_t*)(p.ws + OFF_Y);
#pragma unroll
        for (int r = 0; r < 16; ++r) { int row = rb + 8 * (r >> 2) + 4 * h + (r & 3); Y[(size_t)row * 1024 + col] = tobf(acc[i][jn][r]); }
      } else if (EPI == EPI_XQ) {
        const float sc = LOG2E * 0.0625f;
#pragma unroll
        for (int r = 0; r < 16; ++r) { int row = rb + 8 * (r >> 2) + 4 * h + (r & 3); PROJ[(size_t)row * 1024 + col] = tobf(acc[i][jn][r] * sc); }
      } else if (EPI == EPI_PROJ) {
        if (cb >= DIN) continue;
        if (cb >= 512 && cb < 768) {
          bf16_t* VtA = (bf16_t*)(p.ws + OFF_Y + 72 * MiB);
          int c2 = col - 512; int b = rb / SEQ, tok32 = rb % SEQ;
          bf16_t* rowp = VtA + ((size_t)(b * 4 + (c2 >> 6)) * 64 + (c2 & 63)) * SEQ;
#pragma unroll
          for (int g = 0; g < 4; ++g) store_vt(rowp, tok32, g, h, acc[i][jn][4 * g], acc[i][jn][4 * g + 1], acc[i][jn][4 * g + 2], acc[i][jn][4 * g + 3]);
        } else if (cb >= 1824) {
          bf16_t* VtC = (bf16_t*)(p.ws + OFF_Y + 104 * MiB);
          int c2 = col - 1824; int b = rb / SEQ, tok32 = rb % SEQ;
          bf16_t* rowp = VtC + ((size_t)(b * 2 + (c2 >> 6)) * 64 + (c2 & 63)) * SEQ;
#pragma unroll
          for (int g = 0; g < 4; ++g) store_vt(rowp, tok32, g, h, acc[i][jn][4 * g], acc[i][jn][4 * g + 1], acc[i][jn][4 * g + 2], acc[i][jn][4 * g + 3]);
        } else {
          float sc = 1.f;
          if (cb < 256) sc = LOG2E * 0.17677669529663687f;
          else if (cb >= 1184 && cb < 1696) sc = LOG2E * 0.125f;
#pragma unroll
          for (int r = 0; r < 16; ++r) { int row = rb + 8 * (r >> 2) + 4 * h + (r & 3); PROJ[(size_t)row * 2048 + col] = tobf(acc[i][jn][r] * sc); }
        }
      } else if (EPI == EPI_XKV) {
        if (cb < 1024) {
          bf16_t* KX = (bf16_t*)(p.ws + OFF_SM + 1 * MiB);
#pragma unroll
          for (int r = 0; r < 16; ++r) { int row = rb + 8 * (r >> 2) + 4 * h + (r & 3); KX[(size_t)row * 1024 + col] = tobf(acc[i][jn][r]); }
        } else {
          bf16_t* VtX = (bf16_t*)(p.ws + OFF_SM + 2 * MiB);
          int c2 = col - 1024; int b = rb >> 8, tok32 = rb & 255;
          bf16_t* rowp = VtX + ((size_t)(b * 4 + (c2 >> 8)) * 256 + (c2 & 255)) * 256;
#pragma unroll
          for (int g = 0; g < 4; ++g) store_vt(rowp, tok32, g, h, acc[i][jn][4 * g], acc[i][jn][4 * g + 1], acc[i][jn][4 * g + 2], acc[i][jn][4 * g + 3]);
        }
      } else if (EPI == EPI_QUP) {
        bf16_t* QB = (bf16_t*)(p.ws + OFF_Y + 24 * MiB);
        const float sc = LOG2E * 0.10206207261596575f;
        const bool ropeblk = (cb % 96) == 64;
        const float inv = rope_inv(l31 & 15);
#pragma unroll
        for (int r = 0; r < 16; ++r) {
          int row = rb + 8 * (r >> 2) + 4 * h + (r & 3);
          float v = acc[i][jn][r] * sc;
          if (ropeblk) {
            float other = __shfl_xor(v, 16);
            float ang = (float)p.pos[row] * inv;
            float s, c; sincos_red(ang, s, c);
            v = (l31 < 16) ? (v * c - other * s) : (other * s + v * c);
          }
          QB[(size_t)row * 384 + col] = tobf(v);
        }
      } else if (EPI == EPI_KVUP) {
        int head = cb >> 7, within = cb & 127;
        if (within < 64) {
          bf16_t* KB = (bf16_t*)(p.ws + OFF_Y + 48 * MiB);
#pragma unroll
          for (int r = 0; r < 16; ++r) { int row = rb + 8 * (r >> 2) + 4 * h + (r & 3); KB[(size_t)row * 384 + head * 96 + within + l31] = tobf(acc[i][jn][r]); }
        } else {
          bf16_t* VtB = (bf16_t*)(p.ws + OFF_Y + 88 * MiB);
          int dv = within - 64 + l31; int b = rb / SEQ, tok32 = rb % SEQ;
          bf16_t* rowp = VtB + ((size_t)(b * 4 + head) * 64 + dv) * SEQ;
#pragma unroll
          for (int g = 0; g < 4; ++g) store_vt(rowp, tok32, g, h, acc[i][jn][4 * g], acc[i][jn][4 * g + 1], acc[i][jn][4 * g + 2], acc[i][jn][4 * g + 3]);
        }
      } else if (EPI == EPI_SWIGLU) {
        if ((jn & 1) == 0) {
          bf16_t* F = (bf16_t*)(p.ws + OFF_BIG);
          const int oc = (cb >> 1) + l31;
#pragma unroll
          for (int r = 0; r < 16; ++r) {
            int row = rb + 8 * (r >> 2) + 4 * h + (r & 3);
            float g = acc[i][jn][r], u = acc[i][jn + 1 < NB ? jn + 1 : jn][r];
            float sg = g / (1.f + fexp2(-g * LOG2E));
            F[(size_t)row * DFF + oc] = tobf(sg * u);
          }
        }
      }
    }
  }
}

template <int EPI>
DI void gemm_phase(const Params& p, char* smem, const bf16_t* A, int lda, const bf16_t* Wt, int K, int nM, int nN, int xcdmap) {
  const int tid = opaque_tid(), lane = tid & 63, w = tid >> 6, l31 = lane & 31, h = lane >> 5;
  const int wm = w >> 1, wn = w & 1;
  bf16_t* sm = (bf16_t*)smem;
  constexpr int LDSROW = 72;
  constexpr int BUFE = 256 * LDSROW;
  const int nk = K >> 6;
  int total, start, step;
  const int xcd = blockIdx.x & 7;
  if (xcdmap) { total = (nM >> 3) * nN; start = blockIdx.x >> 3; step = gridDim.x >> 3; }
  else { total = nM * nN; start = blockIdx.x; step = gridDim.x; }
  for (int j = start; j < total; j += step) {
    int mt, nt;
    if (xcdmap) { int g = j / (8 * nN), r = j % (8 * nN); nt = r >> 3; mt = xcd * (nM >> 3) + g * 8 + (r & 7); }
    else { mt = j / nN; nt = j % nN; }
    const int m0 = mt * 128, n0 = nt * 128;
    const bf16_t* Ag = A + (size_t)m0 * lda;
    const bf16_t* Bg = Wt + (size_t)n0 * K;
    f32x16 acc[2][2];
#pragma unroll
    for (int i = 0; i < 2; ++i)
#pragma unroll
      for (int jn = 0; jn < 2; ++jn)
#pragma unroll
        for (int r = 0; r < 16; ++r) acc[i][jn][r] = 0.f;
    u32x4 ra0[4], rb0[4], ra1[4], rb1[4];
#define G_LOAD(RA, RB, kt_) do { _Pragma("unroll") for (int i_ = 0; i_ < 4; ++i_) { int c_ = tid + 256 * i_, row_ = c_ >> 3, ch_ = c_ & 7; \
      RA[i_] = *(const u32x4*)(Ag + (size_t)row_ * lda + (kt_) * 64 + ch_ * 8); RB[i_] = *(const u32x4*)(Bg + (size_t)row_ * K + (kt_) * 64 + ch_ * 8); } } while (0)
#define G_STORE(RA, RB, buf_) do { bf16_t* d_ = sm + (buf_) * BUFE; _Pragma("unroll") for (int i_ = 0; i_ < 4; ++i_) { int c_ = tid + 256 * i_, row_ = c_ >> 3, ch_ = c_ & 7; \
      *(u32x4*)(d_ + row_ * LDSROW + ch_ * 8) = RA[i_]; *(u32x4*)(d_ + (128 + row_) * LDSROW + ch_ * 8) = RB[i_]; } } while (0)
#define G_COMPUTE(buf_) do { const bf16_t* As_ = sm + (buf_) * BUFE; const bf16_t* Bs_ = As_ + 128 * LDSROW; \
      _Pragma("unroll") for (int ks_ = 0; ks_ < 4; ++ks_) { \
        bf16x8 a0_ = *(const bf16x8*)(As_ + (wm * 64 + l31) * LDSROW + ks_ * 16 + 8 * h); \
        bf16x8 a1_ = *(const bf16x8*)(As_ + (wm * 64 + 32 + l31) * LDSROW + ks_ * 16 + 8 * h); \
        bf16x8 b0_ = *(const bf16x8*)(Bs_ + (wn * 64 + l31) * LDSROW + ks_ * 16 + 8 * h); \
        bf16x8 b1_ = *(const bf16x8*)(Bs_ + (wn * 64 + 32 + l31) * LDSROW + ks_ * 16 + 8 * h); \
        acc[0][0] = mfma32(a0_, b0_, acc[0][0]); acc[0][1] = mfma32(a0_, b1_, acc[0][1]); \
        acc[1][0] = mfma32(a1_, b0_, acc[1][0]); acc[1][1] = mfma32(a1_, b1_, acc[1][1]); } } while (0)
    G_LOAD(ra0, rb0, 0);
    G_STORE(ra0, rb0, 0);
    G_LOAD(ra0, rb0, 1);
    if (nk > 2) G_LOAD(ra1, rb1, 2);
    __syncthreads();
    for (int kt = 0; kt < nk; kt += 2) {
      G_COMPUTE(0);
      G_STORE(ra0, rb0, 1);
      if (kt + 3 < nk) G_LOAD(ra0, rb0, kt + 3);
      __syncthreads();
      G_COMPUTE(1);
      if (kt + 2 < nk) G_STORE(ra1, rb1, 0);
      if (kt + 4 < nk) G_LOAD(ra1, rb1, kt + 4);
      __syncthreads();
    }
#undef G_LOAD
#undef G_STORE
#undef G_COMPUTE
    gemm_epilogue<EPI, 2>(p, acc, m0, n0, wm, wn, l31, h);
  }
}

template <int EPI>
DI void gemm_phase_w(const Params& p, char* smem, const bf16_t* A, int lda, const bf16_t* Wt, int K, int nM, int nN) {
  const int tid = opaque_tid(), lane = tid & 63, w = tid >> 6, l31 = lane & 31, h = lane >> 5;
  const int wm = w >> 1, wn = w & 1;
  bf16_t* sm = (bf16_t*)smem;
  constexpr int LR = 40;
  constexpr int BUFE = 384 * LR;
  const int nk = K >> 5;
  const int xcd = blockIdx.x & 7;
  const int total = (nM >> 3) * nN, start = blockIdx.x >> 3, step = gridDim.x >> 3;
  for (int j = start; j < total; j += step) {
    const int g = j / (8 * nN), r8 = j % (8 * nN);
    const int nt = r8 >> 3, mt = xcd * (nM >> 3) + g * 8 + (r8 & 7);
    const int m0 = mt * 128, n0 = nt * 256;
    const bf16_t* Ag = A + (size_t)m0 * lda;
    const bf16_t* Bg = Wt + (size_t)n0 * K;
    f32x16 acc[2][4];
#pragma unroll
    for (int i = 0; i < 2; ++i)
#pragma unroll
      for (int jn = 0; jn < 4; ++jn)
#pragma unroll
        for (int r = 0; r < 16; ++r) acc[i][jn][r] = 0.f;
    u32x4 ra[2], rb[4];
#define W_LOAD(kt_) do { \
      _Pragma("unroll") for (int i_ = 0; i_ < 2; ++i_) { int c_ = tid + 256 * i_, row_ = c_ >> 2, ch_ = c_ & 3; ra[i_] = *(const u32x4*)(Ag + (size_t)row_ * lda + (kt_) * 32 + ch_ * 8); } \
      _Pragma("unroll") for (int i_ = 0; i_ < 4; ++i_) { int c_ = tid + 256 * i_, row_ = c_ >> 2, ch_ = c_ & 3; rb[i_] = *(const u32x4*)(Bg + (size_t)row_ * K + (kt_) * 32 + ch_ * 8); } } while (0)
#define W_STORE(buf_) do { bf16_t* d_ = sm + (buf_) * BUFE; \
      _Pragma("unroll") for (int i_ = 0; i_ < 2; ++i_) { int c_ = tid + 256 * i_, row_ = c_ >> 2, ch_ = c_ & 3; *(u32x4*)(d_ + row_ * LR + ch_ * 8) = ra[i_]; } \
      _Pragma("unroll") for (int i_ = 0; i_ < 4; ++i_) { int c_ = tid + 256 * i_, row_ = c_ >> 2, ch_ = c_ & 3; *(u32x4*)(d_ + (128 + row_) * LR + ch_ * 8) = rb[i_]; } } while (0)
    W_LOAD(0); W_STORE(0);
    __syncthreads();
    for (int kt = 0; kt < nk; ++kt) {
      const bool more = (kt + 1 < nk);
      if (more) W_LOAD(kt + 1);
      const bf16_t* As = sm + (kt & 1) * BUFE;
      const bf16_t* Bs = As + 128 * LR;
#pragma unroll
      for (int ks = 0; ks < 2; ++ks) {
        bf16x8 a0 = *(const bf16x8*)(As + (wm * 64 + l31) * LR + ks * 16 + 8 * h);
        bf16x8 a1 = *(const bf16x8*)(As + (wm * 64 + 32 + l31) * LR + ks * 16 + 8 * h);
#pragma unroll
        for (int jn = 0; jn < 4; ++jn) {
          bf16x8 b = *(const bf16x8*)(Bs + (wn * 128 + jn * 32 + l31) * LR + ks * 16 + 8 * h);
          acc[0][jn] = mfma32(a0, b, acc[0][jn]);
          acc[1][jn] = mfma32(a1, b, acc[1][jn]);
        }
      }
      if (more) W_STORE((kt + 1) & 1);
      __syncthreads();
    }
#undef W_LOAD
#undef W_STORE
    gemm_epilogue<EPI, 4>(p, acc, m0, n0, wm, wn, l31, h);
  }
}

#define RAW_BARRIER() do { asm volatile("s_waitcnt lgkmcnt(0)" ::: "memory"); __builtin_amdgcn_s_barrier(); } while (0)
typedef __attribute__((address_space(3))) unsigned lds_u32;
template <int EPI>
DI void gemm_phase_g(const Params& p, char* smem, const bf16_t* A, int lda, const bf16_t* Wt, int K, int nM, int nN) {
  const int tid = opaque_tid(), lane = tid & 63, w = tid >> 6, l31 = lane & 31, h = lane >> 5;
  const int wm = w >> 1, wn = w & 1;
  constexpr int STAGE = 24576;
  const int nk = K >> 5;
  const int xcd = blockIdx.x & 7;
  const int total = (nM >> 3) * nN, start = blockIdx.x >> 3, step = gridDim.x >> 3;
  const int rip = lane >> 2, gch = (lane & 3) ^ ((lane >> 4) & 3);
  const int fsw = (l31 >> 2) & 3;
  const int lo0 = (l31 >> 4) * 1024 + (l31 & 15) * 64 + ((h ^ fsw) * 16);
  const int lo1 = (l31 >> 4) * 1024 + (l31 & 15) * 64 + (((2 + h) ^ fsw) * 16);
  const int wuni = __builtin_amdgcn_readfirstlane(w);
  const unsigned ldsA = (unsigned)(size_t)smem + (unsigned)(wm * 4096);
  const unsigned ldsB = (unsigned)(size_t)smem + 8192u + (unsigned)(wn * 8192);
  for (int j = start; j < total; j += step) {
    const int g = j / (8 * nN), r8 = j % (8 * nN);
    const int nt = r8 >> 3, mt = xcd * (nM >> 3) + g * 8 + (r8 & 7);
    const int m0 = mt * 128, n0 = nt * 256;
    const bf16_t* srcA0 = A + (size_t)(m0 + 16 * w + rip) * lda + gch * 8;
    const bf16_t* srcB0 = Wt + (size_t)(n0 + 16 * w + rip) * K + gch * 8;
    f32x16 acc[2][4];
#pragma unroll
    for (int i = 0; i < 2; ++i)
#pragma unroll
      for (int jn = 0; jn < 4; ++jn)
#pragma unroll
        for (int r = 0; r < 16; ++r) acc[i][jn][r] = 0.f;
#define GLDS_STEP(kt_, st_) do { \
      char* sb_ = smem + (st_) * STAGE + wuni * 1024; \
      _Pragma("unroll") for (int i_ = 0; i_ < 2; ++i_) \
        __builtin_amdgcn_global_load_lds((const unsigned*)(srcA0 + (size_t)(64 * i_) * lda + (kt_) * 32), (lds_u32*)(sb_ + i_ * 4096), 16, 0, 0); \
      _Pragma("unroll") for (int i_ = 0; i_ < 4; ++i_) \
        __builtin_amdgcn_global_load_lds((const unsigned*)(srcB0 + (size_t)(64 * i_) * K + (kt_) * 32), (lds_u32*)(sb_ + 8192 + i_ * 4096), 16, 0, 0); \
    } while (0)
    GLDS_STEP(0, 0);
    GLDS_STEP(1, 1);
    int st = 0;
    for (int kt = 0; kt < nk; ++kt) {
      if (kt + 1 < nk) asm volatile("s_waitcnt vmcnt(6)" ::: "memory");
      else asm volatile("s_waitcnt vmcnt(0)" ::: "memory");
      RAW_BARRIER();
      if (kt + 2 < nk) { const int st2 = (st >= 1) ? st - 1 : 2; GLDS_STEP(kt + 2, st2); }
      const unsigned sa = ldsA + st * STAGE, sbb = ldsB + st * STAGE;
      bf16x8 fa0, fa1, fb0, fb1, fb2, fb3, ga0, ga1, gb0, gb1, gb2, gb3;
      asm volatile(
          "ds_read_b128 %0, %12\n\tds_read_b128 %1, %12 offset:2048\n\t"
          "ds_read_b128 %2, %13\n\tds_read_b128 %3, %13 offset:2048\n\tds_read_b128 %4, %13 offset:4096\n\tds_read_b128 %5, %13 offset:6144\n\t"
          "ds_read_b128 %6, %14\n\tds_read_b128 %7, %14 offset:2048\n\t"
          "ds_read_b128 %8, %15\n\tds_read_b128 %9, %15 offset:2048\n\tds_read_b128 %10, %15 offset:4096\n\tds_read_b128 %11, %15 offset:6144\n\t"
          "s_waitcnt lgkmcnt(6)"
          : "=&v"(fa0), "=&v"(fa1), "=&v"(fb0), "=&v"(fb1), "=&v"(fb2), "=&v"(fb3),
            "=&v"(ga0), "=&v"(ga1), "=&v"(gb0), "=&v"(gb1), "=&v"(gb2), "=&v"(gb3)
          : "v"(sa + lo0), "v"(sbb + lo0), "v"(sa + lo1), "v"(sbb + lo1)
          : "memory");
      __builtin_amdgcn_s_setprio(1);
      acc[0][0] = mfma32(fa0, fb0, acc[0][0]); acc[1][0] = mfma32(fa1, fb0, acc[1][0]);
      acc[0][1] = mfma32(fa0, fb1, acc[0][1]); acc[1][1] = mfma32(fa1, fb1, acc[1][1]);
      acc[0][2] = mfma32(fa0, fb2, acc[0][2]); acc[1][2] = mfma32(fa1, fb2, acc[1][2]);
      acc[0][3] = mfma32(fa0, fb3, acc[0][3]); acc[1][3] = mfma32(fa1, fb3, acc[1][3]);
      asm volatile("s_waitcnt lgkmcnt(0)" : "+v"(ga0), "+v"(ga1), "+v"(gb0), "+v"(gb1), "+v"(gb2), "+v"(gb3) : : "memory");
      acc[0][0] = mfma32(ga0, gb0, acc[0][0]); acc[1][0] = mfma32(ga1, gb0, acc[1][0]);
      acc[0][1] = mfma32(ga0, gb1, acc[0][1]); acc[1][1] = mfma32(ga1, gb1, acc[1][1]);
      acc[0][2] = mfma32(ga0, gb2, acc[0][2]); acc[1][2] = mfma32(ga1, gb2, acc[1][2]);
      acc[0][3] = mfma32(ga0, gb3, acc[0][3]); acc[1][3] = mfma32(ga1, gb3, acc[1][3]);
      __builtin_amdgcn_s_setprio(0);
      st = (st == 2) ? 0 : st + 1;
    }
    __syncthreads();
#undef GLDS_STEP
    gemm_epilogue<EPI, 4>(p, acc, m0, n0, wm, wn, l31, h);
  }
}

template <int DQK, int NMAP, int DV, int KIND, bool PREFETCH, bool AUG, bool FAST>
DI void attn_tiles(char* smem, int tid, const bf16_t* Kp, int ldk, const bf16_t* Vt, int ldv, int kt0, int kt1,
                   unsigned long long tm0, unsigned long long tm1, unsigned long long tm2, unsigned long long tm3,
                   const int* posk, const float* pmm, float slope2, float pq, int qidx, float qmin,
                   const bf16x8 (&qf)[NMAP][DQK / 16], bf16x8 qaugP,
                   f32x16 (&O)[NMAP][DV / 32], float (&mrun)[NMAP], float (&lrun)[NMAP]) {
  constexpr bool USEMASK = (KIND == 0);
  constexpr bool LSUM = (KIND == 0) && AUG && FAST;
  constexpr bool SEQM = ((KIND == 1) && FAST);
  constexpr bool QLDS = (KIND == 0);
  constexpr bool POS = (!AUG) && (KIND == 0 || KIND == 2);
  constexpr int KAUG = (KIND == 0) ? 16 : 0;
  constexpr bool KSHARE = (KIND == 1);
  constexpr int KD = KSHARE ? DQK : NMAP * DQK;
  constexpr int KROW = KD + KAUG + 8, VROW = 72;
  constexpr int KBYTES = 64 * KROW * 2, VBYTES = DV * VROW * 2, BUFBYTES = KBYTES + VBYTES + 512;
  constexpr int CH = KD / 8, KCH = CH / 4, VCH = DV / 32;
  constexpr int NKS = DQK / 16, NDB = DV / 32;
  const int lane = tid & 63, l31 = lane & 31, h = lane >> 5;

  u32x4 kreg[KCH], vreg[VCH]; float pkreg = 0.f, kmnreg = 0.f;
#define LOAD_REGS(kt_) do { int tl_ = tid; if (KIND == 1) asm volatile("" : "+v"(tl_));   \
    _Pragma("unroll") for (int i_ = 0; i_ < KCH; ++i_) { int c_ = tl_ + 256 * i_, row_ = c_ / CH, ch_ = c_ % CH; kreg[i_] = *(const u32x4*)(Kp + (size_t)((kt_) * 64 + row_) * ldk + ch_ * 8); } \
    _Pragma("unroll") for (int i_ = 0; i_ < VCH; ++i_) { int c_ = tl_ + 256 * i_, row_ = c_ >> 3, ch_ = c_ & 7; vreg[i_] = *(const u32x4*)(Vt + (size_t)row_ * ldv + (kt_) * 64 + ch_ * 8); } \
    if (POS || AUG) { pkreg = (float)posk[(kt_) * 64 + (tid & 63)]; } \
    if (AUG) { kmnreg = pmm[2 * (kt_)]; } } while (0)
#define COPY_TILE(kt_) do { \
    bf16_t* Ks_ = (bf16_t*)smem; bf16_t* Vs_ = (bf16_t*)(smem + KBYTES); \
    _Pragma("unroll") for (int i0_ = 0; i0_ < KCH; i0_ += 4) { \
      u32x4 t_[4]; \
      _Pragma("unroll") for (int i_ = 0; i_ < 4; ++i_) if (i0_ + i_ < KCH) { int c_ = tid + 256 * (i0_ + i_), row_ = c_ / CH, ch_ = c_ % CH; t_[i_] = *(const u32x4*)(Kp + (size_t)((kt_) * 64 + row_) * ldk + ch_ * 8); } \
      _Pragma("unroll") for (int i_ = 0; i_ < 4; ++i_) if (i0_ + i_ < KCH) { int c_ = tid + 256 * (i0_ + i_), row_ = c_ / CH, ch_ = c_ % CH; *(u32x4*)(Ks_ + row_ * KROW + ch_ * 8) = t_[i_]; } \
      __builtin_amdgcn_sched_barrier(0); } \
    _Pragma("unroll") for (int i_ = 0; i_ < VCH; ++i_) { int c_ = tid + 256 * i_, row_ = c_ >> 3, ch_ = c_ & 7; u32x4 t_ = *(const u32x4*)(Vt + (size_t)row_ * ldv + (kt_) * 64 + ch_ * 8); *(u32x4*)(Vs_ + row_ * VROW + ch_ * 8) = t_; } \
    } while (0)
#define STORE_REGS(buf_) do { int ts_ = tid; if (KIND == 1) asm volatile("" : "+v"(ts_)); \
    char* base_ = smem + (buf_) * BUFBYTES; \
    bf16_t* Ks_ = (bf16_t*)base_; bf16_t* Vs_ = (bf16_t*)(base_ + KBYTES); float* Ps_ = (float*)(base_ + KBYTES + VBYTES); \
    _Pragma("unroll") for (int i_ = 0; i_ < KCH; ++i_) { int c_ = ts_ + 256 * i_, row_ = c_ / CH, ch_ = c_ % CH; *(u32x4*)(Ks_ + row_ * KROW + ch_ * 8) = kreg[i_]; } \
    _Pragma("unroll") for (int i_ = 0; i_ < VCH; ++i_) { int c_ = ts_ + 256 * i_, row_ = c_ >> 3, ch_ = c_ & 7; *(u32x4*)(Vs_ + row_ * VROW + ch_ * 8) = vreg[i_]; } \
    if (POS) { if (tid < 64) Ps_[tid] = pkreg; } \
    if (AUG) { if (tid < 64) { \
        const float b_ = slope2 * (pkreg - kmnreg); const float bh_ = frombf(tobf(b_)), bm_ = frombf(tobf(b_ - bh_)), bl_ = frombf(tobf(b_ - bh_ - bm_)); \
        const float c_ = (kmnreg <= qmin) ? -slope2 * (qmin - kmnreg) : slope2 * (qmin - kmnreg); \
        const float ch_ = frombf(tobf(c_)), cm_ = frombf(tobf(c_ - ch_)), cl_ = frombf(tobf(c_ - ch_ - cm_)); \
        uint32_t on2_ = 0x3f803f80u, zz2_ = 0u; asm volatile("" : "+v"(on2_), "+v"(zz2_));     \
        u32x4 a0_, a1_; a0_[0] = on2_; a0_[1] = pack2(1.f, bh_); a0_[2] = pack2(bm_, bl_); a0_[3] = on2_; \
        a1_[0] = pack2(1.f, ch_); a1_[1] = pack2(cm_, cl_); a1_[2] = zz2_; a1_[3] = zz2_; \
        *(u32x4*)(Ks_ + tid * KROW + KD) = a0_; *(u32x4*)(Ks_ + tid * KROW + KD + 8) = a1_; \
        if (tid == 0) Ps_[64] = kmnreg; } } } while (0)

  int ntiles, glin = kt0, gword = 0; unsigned long long gcur = tm0;
  if (USEMASK) ntiles = __builtin_popcountll(tm0) + __builtin_popcountll(tm1) + __builtin_popcountll(tm2) + __builtin_popcountll(tm3);
  else ntiles = kt1 - kt0;
#define NEXT_TILE(dst_) do { if (USEMASK) { \
      while (gcur == 0ull && gword < 3) { ++gword; gcur = (gword == 1) ? tm1 : ((gword == 2) ? tm2 : tm3); } \
      dst_ = gword * 64 + (int)__builtin_ctzll(gcur); gcur &= gcur - 1ull; } else { dst_ = glin++; } } while (0)
  if (ntiles <= 0) return;
  int ktc; NEXT_TILE(ktc);

  __syncthreads();
  f32x16 Lacc[NMAP]; bf16x8 aones = {0, 0, 0, 0, 0, 0, 0, 0};
  if (LSUM) {
    uint32_t on_ = (l31 == 0) ? 0x3f803f80u : 0u; asm volatile("" : "+v"(on_));
    u32x4 ou; ou[0] = ou[1] = ou[2] = ou[3] = on_; aones = __builtin_bit_cast(bf16x8, ou);
#pragma unroll
    for (int m = 0; m < NMAP; ++m) {
      const float lt = lrun[m] + __shfl_xor(lrun[m], 32);
#pragma unroll
      for (int r = 0; r < 16; ++r) Lacc[m][r] = 0.f;
      Lacc[m][0] = h ? 0.f : lt;
      lrun[m] = 0.f;
    }
  }
  bool seeded = false;
  if (AUG) {
    seeded = (__builtin_amdgcn_ballot_w64(mrun[0] < -1e29f) == 0ull);
    if (seeded) {
#pragma unroll
      for (int m = 0; m < NMAP; ++m) {
        const float nm = -mrun[m];
        const float nh = frombf(tobf(nm)), nmd = frombf(tobf(nm - nh)), nl = frombf(tobf(nm - nh - nmd));
        uint32_t* qap = (uint32_t*)(smem + 2 * BUFBYTES + 128 * 72 * 2 + m * 4096 + tid * 16);
        if (h) qap[0] = pack2(nl, 1.f); else qap[3] = pack2(nh, nmd);
      }
    }
  }
  if (PREFETCH) { LOAD_REGS(ktc); STORE_REGS(0); } else { COPY_TILE(ktc); }
  __syncthreads();

#pragma unroll 1
  for (int it = 0; it < ntiles; ++it) {
    const int cur = PREFETCH ? (it & 1) : 0;
    const bool more = (it + 1 < ntiles);
    int ktn = ktc;
    if (more) NEXT_TILE(ktn);
    if (PREFETCH && more) LOAD_REGS(ktn);
    {
      const char* base = smem + cur * BUFBYTES;
      const bf16_t* Ks = (const bf16_t*)base; const bf16_t* Vs = (const bf16_t*)(base + KBYTES); const float* Ps = (const float*)(base + KBYTES + VBYTES);
      const float cbias = 0.f; uint32_t sgn = 0u;
      if (AUG) {
        const float kmn = Ps[64];
        const bool left = (kmn <= qmin);
        sgn = (left || h) ? 0u : 0x80008000u;
      }
#pragma unroll
      for (int mm = 0; mm < (SEQM ? NMAP : 1); ++mm) {
      const int mlo = SEQM ? mm : 0, mhi = SEQM ? mm + 1 : NMAP;
      f32x16 SS[NMAP][2];
#pragma unroll
      for (int m = mlo; m < mhi; ++m) {
#pragma unroll
        for (int mb = 0; mb < 2; ++mb)
#pragma unroll
          for (int r = 0; r < 16; ++r) SS[m][mb][r] = 0.f;
#pragma unroll
        for (int ks = 0; ks < NKS; ++ks) {
          bf16x8 a0 = *(const bf16x8*)(Ks + (l31) * KROW + (KSHARE ? 0 : m * DQK) + ks * 16 + 8 * h);
          bf16x8 a1 = *(const bf16x8*)(Ks + (32 + l31) * KROW + (KSHARE ? 0 : m * DQK) + ks * 16 + 8 * h);
          bf16x8 qv;
          if (QLDS) qv = *(const bf16x8*)((const bf16_t*)(smem + 2 * BUFBYTES) + ((tid >> 6) * 32 + l31) * 72 + m * DQK + ks * 16 + 8 * h);
          else if (KSHARE && m == 1) qv = *(const bf16x8*)((const bf16_t*)(smem + 2 * BUFBYTES) + ((tid >> 6) * 32 + l31) * (DQK + 8) + ks * 16 + 8 * h);
          else qv = qf[m][ks];
          SS[m][0] = mfma32(a0, qv, SS[m][0]);
          SS[m][1] = mfma32(a1, qv, SS[m][1]);
          if ((ks & 1) == 1) __builtin_amdgcn_sched_barrier(0);
        }
        if (AUG) {
          bf16x8 a0 = *(const bf16x8*)(Ks + (l31) * KROW + KD + 8 * h);
          bf16x8 a1 = *(const bf16x8*)(Ks + (32 + l31) * KROW + KD + 8 * h);
          u32x4 qu = *(const u32x4*)(smem + 2 * BUFBYTES + 128 * 72 * 2 + m * 4096 + tid * 16);
          qu[0] ^= sgn; qu[1] ^= sgn; qu[2] ^= sgn;
          const bf16x8 qa = __builtin_bit_cast(bf16x8, qu);
          SS[m][0] = mfma32(a0, qa, SS[m][0]);
          SS[m][1] = mfma32(a1, qa, SS[m][1]);
        }
        __builtin_amdgcn_sched_barrier(0);
      }
#pragma unroll
      for (int m = mlo; m < mhi; ++m) {
        f32x16 (&S)[2] = SS[m];
        if (POS) {
#pragma unroll
          for (int mb = 0; mb < 2; ++mb)
#pragma unroll
            for (int g = 0; g < 4; ++g) {
              float4 pk4 = *(const float4*)(Ps + mb * 32 + 8 * g + 4 * h);
#pragma unroll
              for (int i = 0; i < 4; ++i) {
                const float pkv = (i == 0) ? pk4.x : (i == 1) ? pk4.y : (i == 2) ? pk4.z : pk4.w;
                float s = S[mb][4 * g + i] - slope2 * fabsf(pq - pkv);
                if (KIND == 2) {
                  int kidx = ktc * 64 + mb * 32 + 8 * g + 4 * h + i;
                  int dd = kidx - qidx; dd = dd < 0 ? -dd : dd;
                  if (dd > 128) s = -1e30f;
                }
                S[mb][4 * g + i] = s;
              }
            }
        }
        __builtin_amdgcn_sched_barrier(0);
        float mx = S[0][0];
        if (!FAST) {
#pragma unroll
          for (int mb = 0; mb < 2; ++mb)
#pragma unroll
            for (int r = 0; r < 16; ++r) mx = fmaxf(mx, S[mb][r]);
        }
        float rs = 0.f;
        if (FAST) {
#pragma unroll
          for (int mb = 0; mb < 2; ++mb)
#pragma unroll
            for (int r = 0; r < 16; ++r) {
              float pv = fexp2(S[mb][r]); S[mb][r] = pv; if (!LSUM) rs += pv;
              if ((r & 7) == 7) __builtin_amdgcn_sched_barrier(0);
            }
        } else if (AUG) {
          mx = half_max(mx) + cbias;
          bool fix = false; float dlt = 0.f;
          if (it == 0 && !seeded) { dlt = mx; mrun[m] = mx; fix = true; }
          else if (__builtin_amdgcn_ballot_w64(mx > 0.f) != 0ull) {
            dlt = fmaxf(mx, 0.f);
            const float alpha = fexp2(-dlt);
            mrun[m] += dlt;
            lrun[m] *= alpha;
#pragma unroll
            for (int db = 0; db < NDB; ++db)
#pragma unroll
              for (int r = 0; r < 16; ++r) O[m][db][r] *= alpha;
            fix = true;
          }
          if (fix) {
#pragma unroll
            for (int mb = 0; mb < 2; ++mb)
#pragma unroll
              for (int r = 0; r < 16; ++r) S[mb][r] -= dlt;
            const float nm = -mrun[m];
            const float nh = frombf(tobf(nm)), nmd = frombf(tobf(nm - nh)), nl = frombf(tobf(nm - nh - nmd));
            uint32_t* qap = (uint32_t*)(smem + 2 * BUFBYTES + 128 * 72 * 2 + m * 4096 + tid * 16);
            if (h) qap[0] = pack2(nl, 1.f); else qap[3] = pack2(nh, nmd);
          }
#pragma unroll
          for (int mb = 0; mb < 2; ++mb)
#pragma unroll
            for (int r = 0; r < 16; ++r) { float pv = fexp2(S[mb][r]); S[mb][r] = pv; rs += pv; }
        } else {
          mx = half_max(mx) + cbias;
          if (__builtin_amdgcn_ballot_w64(mx > mrun[m]) != 0ull) {
            const float mnew = fmaxf(mrun[m], mx);
            const float alpha = fexp2(mrun[m] - mnew);
            mrun[m] = mnew;
            lrun[m] *= alpha;
#pragma unroll
            for (int db = 0; db < NDB; ++db)
#pragma unroll
              for (int r = 0; r < 16; ++r) O[m][db][r] *= alpha;
          }
          const float msub = mrun[m] - cbias;
#pragma unroll
          for (int mb = 0; mb < 2; ++mb)
#pragma unroll
            for (int r = 0; r < 16; ++r) { float pv = fexp2(S[mb][r] - msub); S[mb][r] = pv; rs += pv; }
        }
        lrun[m] += rs;
        bf16x8 pf[4];
#pragma unroll
        for (int mb = 0; mb < 2; ++mb)
#pragma unroll
          for (int s = 0; s < 2; ++s) {
            u32x4 u;
            u[0] = pack2(S[mb][8 * s + 0], S[mb][8 * s + 1]); u[1] = pack2(S[mb][8 * s + 2], S[mb][8 * s + 3]);
            u[2] = pack2(S[mb][8 * s + 4], S[mb][8 * s + 5]); u[3] = pack2(S[mb][8 * s + 6], S[mb][8 * s + 7]);
            pf[mb * 2 + s] = __builtin_bit_cast(bf16x8, u);
          }
        if (LSUM) {
#pragma unroll
          for (int kk = 0; kk < 4; ++kk) Lacc[m] = mfma32(aones, pf[kk], Lacc[m]);
        }
#pragma unroll
        for (int db = 0; db < NDB; ++db) {
#pragma unroll
          for (int kk = 0; kk < 4; ++kk) {
            bf16x8 a = *(const bf16x8*)(Vs + (db * 32 + l31) * VROW + kk * 16 + 8 * h);
            O[m][db] = mfma32(a, pf[kk], O[m][db]);
          }
          __builtin_amdgcn_sched_barrier(0);
        }
      }
      }
    }
    if (PREFETCH) {
      if (more) STORE_REGS(cur ^ 1);
      __syncthreads();
    } else {
      __syncthreads();
      if (more) { COPY_TILE(ktn); __syncthreads(); }
    }
    ktc = ktn;
  }
  if (LSUM) {
#pragma unroll
    for (int m = 0; m < NMAP; ++m) lrun[m] = h ? 0.f : Lacc[m][0];
  }
}
#undef NEXT_TILE
#undef LOAD_REGS
#undef COPY_TILE
#undef STORE_REGS

template <int DQK, int NMAP, int DV, int KIND, bool PREFETCH, bool FAST>
DI bool attn_unit(char* smem, const bf16_t* Qp, int ldq, const bf16_t* Kp, int ldk, const bf16_t* Vt, int ldv,
                  int kt0, int kt1, const int* posq, const int* posk, const float* pmm, float slope2, float sink2, int q0idx,
                  float lam, const float* headg, float outscale, bf16_t* Op, int ldo) {
  constexpr int NKS = DQK / 16, NDB = DV / 32;
  const int tid = opaque_tid(), lane = tid & 63, w = tid >> 6, l31 = lane & 31, h = lane >> 5;
  constexpr bool KSHARE = (KIND == 1);
  const int qr = KSHARE ? (64 * w + l31) : (32 * w + l31);

  bf16x8 qf[NMAP][NKS];
  {
    const bf16_t* qrow = Qp + (size_t)qr * ldq;
#pragma unroll
    for (int m = 0; m < NMAP; ++m)
#pragma unroll
      for (int ks = 0; ks < NKS; ++ks) qf[m][ks] = *(const bf16x8*)(qrow + (KSHARE ? (size_t)(32 * m) * ldq : (size_t)(m * DQK)) + ks * 16 + 8 * h);
  }
  float pq = 0.f;
  if (KIND == 0 || KIND == 2) pq = (float)posq[qr];
  const int qidx = q0idx + qr;

  f32x16 O[NMAP][NDB];
  float mrun[NMAP], lrun[NMAP];
#pragma unroll
  for (int m = 0; m < NMAP; ++m) {
#pragma unroll
    for (int db = 0; db < NDB; ++db)
#pragma unroll
      for (int r = 0; r < 16; ++r) O[m][db][r] = 0.f;
    if (KIND == 2) { mrun[m] = sink2; lrun[m] = (h == 0) ? (FAST ? fexp2(sink2) : 1.f) : 0.f; }
    else { mrun[m] = -1e30f; lrun[m] = 0.f; }
  }

  bf16x8 qz = {0, 0, 0, 0, 0, 0, 0, 0};
  if (KSHARE) {
    constexpr int BUFB1 = 64 * (DQK + 8) * 2 + DV * 72 * 2 + 512;
    bf16_t* Qs = (bf16_t*)(smem + 2 * BUFB1) + (w * 32 + l31) * (DQK + 8);
#pragma unroll
    for (int ks = 0; ks < NKS; ++ks) { *(bf16x8*)(Qs + ks * 16 + 8 * h) = qf[NMAP - 1][ks]; qf[NMAP - 1][ks] = qz; }
  }
  if (KIND == 0) {
    {
      constexpr int BUFB0 = 64 * (NMAP * DQK + 16 + 8) * 2 + DV * 72 * 2 + 512;
      bf16_t* Qs = (bf16_t*)(smem + 2 * BUFB0) + (w * 32 + l31) * 72;
#pragma unroll
      for (int m = 0; m < NMAP; ++m)
#pragma unroll
        for (int ks = 0; ks < NKS; ++ks) { *(bf16x8*)(Qs + m * DQK + ks * 16 + 8 * h) = qf[m][ks]; qf[m][ks] = qz; }
    }
    float bmin = fminf((float)posq[lane], (float)posq[lane + 64]), bmax = fmaxf((float)posq[lane], (float)posq[lane + 64]);
#pragma unroll
    for (int o = 32; o >= 1; o >>= 1) { bmin = fminf(bmin, __shfl_xor(bmin, o)); bmax = fmaxf(bmax, __shfl_xor(bmax, o)); }
    unsigned long long mix[4];
#pragma unroll
    for (int j = 0; j < 4; ++j) {
      const int t = j * 64 + lane;
      const float kmn = pmm[2 * t], kmx = pmm[2 * t + 1];
      mix[j] = __builtin_amdgcn_ballot_w64((kmx > bmin) && (kmn < bmax));
    }
    const float a = -slope2 * (pq - bmin);
    const float ah = frombf(tobf(a)), am = frombf(tobf(a - ah)), al = frombf(tobf(a - ah - am));
    u32x4 up;
    if (h) { up[0] = pack2(0.f, 1.f); up[1] = pack2(1.f, 1.f); up[2] = 0u; up[3] = 0u; }
    else   { up[0] = pack2(ah, am); up[1] = pack2(al, 1.f); up[2] = pack2(1.f, 1.f); up[3] = 0u; }
    {
      constexpr int BUFB0 = 64 * (NMAP * DQK + 16 + 8) * 2 + DV * 72 * 2 + 512;
#pragma unroll
      for (int m = 0; m < NMAP; ++m) *(u32x4*)(smem + 2 * BUFB0 + 128 * 72 * 2 + m * 4096 + tid * 16) = up;
    }
    const bf16x8 qaugP = qz;
    attn_tiles<DQK, NMAP, DV, KIND, PREFETCH, false, false>(smem, tid, Kp, ldk, Vt, ldv, kt0, kt1, mix[0], mix[1], mix[2], mix[3],
                                                     posk, pmm, slope2, pq, qidx, bmin, qf, qz, O, mrun, lrun);
    attn_tiles<DQK, NMAP, DV, KIND, PREFETCH, true, FAST>(smem, tid, Kp, ldk, Vt, ldv, kt0, kt1, ~mix[0], ~mix[1], ~mix[2], ~mix[3],
                                                    posk, pmm, slope2, pq, qidx, bmin, qf, qaugP, O, mrun, lrun);
  } else {
    attn_tiles<DQK, NMAP, DV, KIND, PREFETCH, false, FAST>(smem, tid, Kp, ldk, Vt, ldv, kt0, kt1, 0ull, 0ull, 0ull, 0ull,
                                                     posk, pmm, slope2, pq, qidx, 0.f, qf, qz, O, mrun, lrun);
  }

  if (FAST) {
    bool bad = false;
#pragma unroll
    for (int m = 0; m < NMAP; ++m) { const float lt = lrun[m] + __shfl_xor(lrun[m], 32); bad = bad || !(lt > 9.0e-13f && lt < 1.0e18f); }
    __shared__ unsigned sflag[4];
    const unsigned long long bm = __builtin_amdgcn_ballot_w64(bad);
    if (lane == 0) sflag[w] = (bm != 0ull) ? 1u : 0u;
    __syncthreads();
    const unsigned anybad = sflag[0] | sflag[1] | sflag[2] | sflag[3];
    __syncthreads();
    if (anybad) return true;
  }
  float inv[NMAP];
#pragma unroll
  for (int m = 0; m < NMAP; ++m) { float lt = lrun[m] + __shfl_xor(lrun[m], 32); inv[m] = 1.f / lt; }
  bf16_t* orow = Op + (size_t)qr * ldo;
  if (KIND == 0) {
    float ss = 0.f;
#pragma unroll
    for (int db = 0; db < NDB; ++db)
#pragma unroll
      for (int r = 0; r < 16; ++r) {
        float o = O[0][db][r] * inv[0] - lam * (O[NMAP - 1][db][r] * inv[NMAP - 1]);
        O[0][db][r] = o; ss += o * o;
      }
    ss += __shfl_xor(ss, 32);
    const float rs = rsqrtf(ss * (1.f / 64.f) + EPSN) * outscale;
#pragma unroll
    for (int db = 0; db < NDB; ++db)
#pragma unroll
      for (int g = 0; g < 4; ++g) {
        int dv = db * 32 + 8 * g + 4 * h;
        float4 gg = *(const float4*)(headg + dv);
        uint2 u; u.x = pack2(O[0][db][4 * g] * rs * gg.x, O[0][db][4 * g + 1] * rs * gg.y);
        u.y = pack2(O[0][db][4 * g + 2] * rs * gg.z, O[0][db][4 * g + 3] * rs * gg.w);
        *(uint2*)(orow + dv) = u;
      }
  } else {
#pragma unroll
    for (int m = 0; m < (KSHARE ? NMAP : 1); ++m)
#pragma unroll
      for (int db = 0; db < NDB; ++db)
#pragma unroll
        for (int g = 0; g < 4; ++g) {
          int dv = db * 32 + 8 * g + 4 * h;
          uint2 u; u.x = pack2(O[m][db][4 * g] * inv[m], O[m][db][4 * g + 1] * inv[m]);
          u.y = pack2(O[m][db][4 * g + 2] * inv[m], O[m][db][4 * g + 3] * inv[m]);
          *(uint2*)(orow + (size_t)(32 * m) * ldo + dv) = u;
        }
  }
  return false;
}
DI void phase_rows_init_or_res3(const Params& p, int l, bool init, char* smem) {
  const int tid_ = opaque_tid(); const int lane = tid_ & 63, w = tid_ >> 6;
  bf16_t* H = (bf16_t*)(p.ws + OFF_H);
  const bf16_t* Y = (const bf16_t*)(p.ws + OFF_Y);
  const int nl = init ? 0 : l + 1;
  for (int row = blockIdx.x * 4 + w; row < NTOK; row += gridDim.x * 4) {
    size_t ro = (size_t)row * 1024;
    if (init) row_op<false, true>(p.x_in + ro, nullptr, nullptr, nullptr, p.g_mix_pre, H + ro, lane);
    else if (l < DEPTH - 1) row_op<true, true>(p.xres + ro, Y + ro, p.g_ffn_post + l * 1024, p.xres + ro, p.g_mix_pre + (l + 1) * 1024, H + ro, lane);
    else row_op<true, false>(p.xres + ro, Y + ro, p.g_ffn_post + l * 1024, p.xres + ro, nullptr, nullptr, lane);
  }
  if (init) {
    float* PMM = (float*)(p.ws + OFF_SM + 3 * MiB);
    for (int t = blockIdx.x * 4 + w; t < NTOK / 64; t += gridDim.x * 4) {
      float v = (float)p.pos[t * 64 + lane]; float mn = v, mx = v;
#pragma unroll
      for (int o = 32; o >= 1; o >>= 1) { mn = fminf(mn, __shfl_xor(mn, o)); mx = fmaxf(mx, __shfl_xor(mx, o)); }
      if (lane == 0) { PMM[2 * t] = mn; PMM[2 * t + 1] = mx; }
    }
  }
  if (nl < DEPTH) {
    bf16_t* MEMN = (bf16_t*)(p.ws + OFF_SM);
    for (int row = blockIdx.x * 4 + w; row < 512; row += gridDim.x * 4) {
      size_t ro = (size_t)row * 1024;
      row_op<false, true>(p.mem + ro, nullptr, nullptr, nullptr, p.g_x_mem + nl * 1024, MEMN + ro, lane);
    }
    convert_weights(p, nl, smem);
  }
}

DI void phase_rows_res(const Params& p, const float* xsrc, const float* gpost, const float* gnext) {
  const int tid_ = opaque_tid(); const int lane = tid_ & 63, w = tid_ >> 6;
  bf16_t* H = (bf16_t*)(p.ws + OFF_H);
  const bf16_t* Y = (const bf16_t*)(p.ws + OFF_Y);
  for (int row = blockIdx.x * 4 + w; row < NTOK; row += gridDim.x * 4) {
    size_t ro = (size_t)row * 1024;
    row_op<true, true>(xsrc + ro, Y + ro, gpost, p.xres + ro, gnext, H + ro, lane);
  }
}

DI void phase_rows_mla(const Params& p, int l) {
  const int tid_ = opaque_tid(); const int lane = tid_ & 63, w = tid_ >> 6;
  const bf16_t* PROJ = (const bf16_t*)(p.ws + OFF_BIG);
  bf16_t* MLAN = (bf16_t*)(p.ws + OFF_Y);
  bf16_t* KB = (bf16_t*)(p.ws + OFF_Y + 48 * MiB);
  const float* gq = p.mla_q_norm_g + l * 256;
  const float* gkv = p.mla_kv_norm_g + l * 128;
  for (int row = blockIdx.x * 4 + w; row < NTOK; row += gridDim.x * 4) {
    const bf16_t* pr = PROJ + (size_t)row * 2048;
    uint2 cq = *(const uint2*)(pr + 768 + lane * 4);
    uint32_t ckv = *(const uint32_t*)(pr + 1024 + lane * 2);
    float q0 = frombf(cq.x & 0xffffu), q1 = frombf(cq.x >> 16), q2 = frombf(cq.y & 0xffffu), q3 = frombf(cq.y >> 16);
    float k0 = frombf(ckv & 0xffffu), k1 = frombf(ckv >> 16);
    float ssq = wave_sum(q0 * q0 + q1 * q1 + q2 * q2 + q3 * q3);
    float ssk = wave_sum(k0 * k0 + k1 * k1);
    float rq = rsqrtf(ssq * (1.f / 256.f) + EPSN), rk = rsqrtf(ssk * (1.f / 128.f) + EPSN);
    float4 g4 = *(const float4*)(gq + lane * 4);
    float2 g2 = *(const float2*)(gkv + lane * 2);
    uint2 u; u.x = pack2(q0 * rq * g4.x, q1 * rq * g4.y); u.y = pack2(q2 * rq * g4.z, q3 * rq * g4.w);
    *(uint2*)(MLAN + (size_t)row * 384 + lane * 4) = u;
    *(uint32_t*)(MLAN + (size_t)row * 384 + 256 + lane * 2) = pack2(k0 * rk * g2.x, k1 * rk * g2.y);
    if (lane < 16) {
      float x1 = frombf(pr[1152 + lane]), x2 = frombf(pr[1152 + 16 + lane]);
      float ang = (float)p.pos[row] * rope_inv(lane);
      float s, c; sincos_red(ang, s, c);
      bf16_t o1 = tobf(x1 * c - x2 * s), o2 = tobf(x1 * s + x2 * c);
      bf16_t* kb = KB + (size_t)row * 384;
#pragma unroll
      for (int hd = 0; hd < 4; ++hd) { kb[hd * 96 + 64 + lane] = o1; kb[hd * 96 + 80 + lane] = o2; }
    }
  }
}

DI void phase_attn(const Params& p, int l, char* smem) {
  const int xcd = blockIdx.x & 7, slot = blockIdx.x >> 3, nslots = gridDim.x >> 3;
  const bf16_t* PROJ = (const bf16_t*)(p.ws + OFF_BIG);
  bf16_t* MIX = (bf16_t*)(p.ws + OFF_BIG + 128 * MiB);
  const bf16_t* QB = (const bf16_t*)(p.ws + OFF_Y + 24 * MiB);
  const bf16_t* KB = (const bf16_t*)(p.ws + OFF_Y + 48 * MiB);
  const bf16_t* VtA = (const bf16_t*)(p.ws + OFF_Y + 72 * MiB);
  const bf16_t* VtB = (const bf16_t*)(p.ws + OFF_Y + 88 * MiB);
  const bf16_t* VtC = (const bf16_t*)(p.ws + OFF_Y + 104 * MiB);
  const float* PMM = (const float*)(p.ws + OFF_SM + 3 * MiB);
  const float* lp = p.diff_lambda + l * 128;
  float d0 = 0.f, d1 = 0.f;
  for (int i = 0; i < 32; ++i) { d0 += lp[i] * lp[32 + i]; d1 += lp[64 + i] * lp[96 + i]; }
  const float lam_init = __uint_as_float(__builtin_amdgcn_readfirstlane(__float_as_uint(0.8f - 0.6f * expf(-0.3f * (float)l))));
  const float lam = __uint_as_float(__builtin_amdgcn_readfirstlane(__float_as_uint(expf(d0) - expf(d1) + lam_init)));
  const int b = xcd >> 2, head = xcd & 3;
  if (ATT_SEL & 1) {
    const float slope2 = exp2f(-8.f * (float)(9 + head) / 12.f) * LOG2E;
    unsigned failA = 0u; int ia = 0;
    for (int qb = slot; qb < 128; qb += nslots, ++ia) {
      const size_t t0 = (size_t)b * SEQ + qb * 128;
      const bool rd = attn_unit<32, 2, 64, 0, true, true>(smem, PROJ + t0 * 2048 + head * 64, 2048, PROJ + (size_t)b * SEQ * 2048 + 256 + head * 64, 2048,
                                    VtA + (size_t)(b * 4 + head) * 64 * SEQ, SEQ, 0, SEQ / 64, p.pos + t0, p.pos + (size_t)b * SEQ, PMM + b * 512, slope2, 0.f, qb * 128,
                                    lam, p.diff_head_g + l * 64, 1.f - lam_init, MIX + t0 * 1024 + head * 64, 1024);
      if (rd) failA |= 1u << ia;
    }
    ia = 0;
    for (int qb = slot; qb < 128; qb += nslots, ++ia) {
      if (!((failA >> ia) & 1u)) continue;
      const size_t t0 = (size_t)b * SEQ + qb * 128;
      (void)attn_unit<32, 2, 64, 0, true, false>(smem, PROJ + t0 * 2048 + head * 64, 2048, PROJ + (size_t)b * SEQ * 2048 + 256 + head * 64, 2048,
                                    VtA + (size_t)(b * 4 + head) * 64 * SEQ, SEQ, 0, SEQ / 64, p.pos + t0, p.pos + (size_t)b * SEQ, PMM + b * 512, slope2, 0.f, qb * 128,
                                    lam, p.diff_head_g + l * 64, 1.f - lam_init, MIX + t0 * 1024 + head * 64, 1024);
    }
  }
  if (ATT_SEL & 2) {
    unsigned failB = 0u; int ib = 0;
    for (int qb = slot; qb < 64; qb += nslots, ++ib) {
      const size_t t0 = (size_t)b * SEQ + qb * 256;
      const bool rd = attn_unit<96, 2, 64, 1, true, true>(smem, QB + t0 * 384 + head * 96, 384, KB + (size_t)b * SEQ * 384 + head * 96, 384,
                                    VtB + (size_t)(b * 4 + head) * 64 * SEQ, SEQ, 0, SEQ / 64, nullptr, nullptr, nullptr, 0.f, 0.f, qb * 256,
                                    0.f, nullptr, 1.f, MIX + t0 * 1024 + 256 + head * 64, 1024);
      if (rd) failB |= 1u << ib;
    }
    ib = 0;
    for (int qb = slot; qb < 64; qb += nslots, ++ib) {
      if (!((failB >> ib) & 1u)) continue;
      const size_t t0 = (size_t)b * SEQ + qb * 256;
      (void)attn_unit<96, 2, 64, 1, true, false>(smem, QB + t0 * 384 + head * 96, 384, KB + (size_t)b * SEQ * 384 + head * 96, 384,
                                    VtB + (size_t)(b * 4 + head) * 64 * SEQ, SEQ, 0, SEQ / 64, nullptr, nullptr, nullptr, 0.f, 0.f, qb * 256,
                                    0.f, nullptr, 1.f, MIX + t0 * 1024 + 256 + head * 64, 1024);
    }
  }
  unsigned failC = 0u; int ic = 0;
  if (ATT_SEL & 4) for (int j = slot; j < 256; j += nslots, ++ic) {
    const int hq = (xcd & 3) * 2 + (j >> 7), qb = j & 127, kvh = hq >> 2;
    const size_t t0 = (size_t)b * SEQ + qb * 128;
    const float slope2 = exp2f(-8.f * (float)(hq + 1) / 12.f) * LOG2E;
    const float sink2 = p.swa_sinks[l * 8 + hq] * LOG2E;
    int kt0 = 2 * qb - 2, kt1 = 2 * qb + 4;
    if (kt0 < 0) kt0 = 0;
    if (kt1 > SEQ / 64) kt1 = SEQ / 64;
    const bool rd = attn_unit<64, 1, 64, 2, true, true>(smem, PROJ + t0 * 2048 + 1184 + hq * 64, 2048, PROJ + (size_t)b * SEQ * 2048 + 1696 + kvh * 64, 2048,
                                  VtC + (size_t)(b * 2 + kvh) * 64 * SEQ, SEQ, kt0, kt1, p.pos + t0, p.pos + (size_t)b * SEQ, nullptr, slope2, sink2, qb * 128,
                                  0.f, nullptr, 1.f, MIX + t0 * 1024 + 512 + hq * 64, 1024);
    if (rd) failC |= 1u << ic;
  }
  ic = 0;
  if (ATT_SEL & 4) for (int j = slot; j < 256; j += nslots, ++ic) {
    if (!((failC >> ic) & 1u)) continue;
    const int hq = (xcd & 3) * 2 + (j >> 7), qb = j & 127, kvh = hq >> 2;
    const size_t t0 = (size_t)b * SEQ + qb * 128;
    const float slope2 = exp2f(-8.f * (float)(hq + 1) / 12.f) * LOG2E;
    const float sink2 = p.swa_sinks[l * 8 + hq] * LOG2E;
    int kt0 = 2 * qb - 2, kt1 = 2 * qb + 4;
    if (kt0 < 0) kt0 = 0;
    if (kt1 > SEQ / 64) kt1 = SEQ / 64;
    (void)attn_unit<64, 1, 64, 2, true, false>(smem, PROJ + t0 * 2048 + 1184 + hq * 64, 2048, PROJ + (size_t)b * SEQ * 2048 + 1696 + kvh * 64, 2048,
                                  VtC + (size_t)(b * 2 + kvh) * 64 * SEQ, SEQ, kt0, kt1, p.pos + t0, p.pos + (size_t)b * SEQ, nullptr, slope2, sink2, qb * 128,
                                  0.f, nullptr, 1.f, MIX + t0 * 1024 + 512 + hq * 64, 1024);
  }
}

DI void phase_xattn(const Params& p, char* smem) {
  const int xcd = blockIdx.x & 7, slot = blockIdx.x >> 3, nslots = gridDim.x >> 3;
  const bf16_t* QX = (const bf16_t*)(p.ws + OFF_BIG);
  bf16_t* OX = (bf16_t*)(p.ws + OFF_BIG + 64 * MiB);
  const bf16_t* KX = (const bf16_t*)(p.ws + OFF_SM + 1 * MiB);
  const bf16_t* VtX = (const bf16_t*)(p.ws + OFF_SM + 2 * MiB);
  const int b = xcd >> 2, head = xcd & 3;
  unsigned failX = 0u; int ix = 0;
  for (int j = slot; j < 256; j += nslots, ++ix) {
    const int dvh = j >> 7, qb = j & 127;
    const size_t t0 = (size_t)b * SEQ + qb * 128;
    const bool rd = attn_unit<256, 1, 128, 3, false, true>(smem, QX + t0 * 1024 + head * 256, 1024, KX + (size_t)b * 256 * 1024 + head * 256, 1024,
                                     VtX + ((size_t)(b * 4 + head) * 256 + dvh * 128) * 256, 256, 0, 4, nullptr, nullptr, nullptr, 0.f, 0.f, 0,
                                     0.f, nullptr, 1.f, OX + t0 * 1024 + head * 256 + dvh * 128, 1024);
    if (rd) failX |= 1u << ix;
  }
  ix = 0;
  for (int j = slot; j < 256; j += nslots, ++ix) {
    if (!((failX >> ix) & 1u)) continue;
    const int dvh = j >> 7, qb = j & 127;
    const size_t t0 = (size_t)b * SEQ + qb * 128;
    (void)attn_unit<256, 1, 128, 3, false, false>(smem, QX + t0 * 1024 + head * 256, 1024, KX + (size_t)b * 256 * 1024 + head * 256, 1024,
                                     VtX + ((size_t)(b * 4 + head) * 256 + dvh * 128) * 256, 256, 0, 4, nullptr, nullptr, nullptr, 0.f, 0.f, 0,
                                     0.f, nullptr, 1.f, OX + t0 * 1024 + head * 256 + dvh * 128, 1024);
  }
}

DI void run_phase(const Params& p, int ph, char* smem) {
  bf16_t* W = (bf16_t*)(p.ws + OFF_W);
  bf16_t* H = (bf16_t*)(p.ws + OFF_H);
  bf16_t* BIG = (bf16_t*)(p.ws + OFF_BIG);
  if (ph == 0) { phase_rows_init_or_res3(p, 0, true, smem); return; }
  const int l = (ph - 1) / 13, s = (ph - 1) % 13;
  switch (s) {
    case 0:
      gemm_phase_g<EPI_PROJ>(p, smem, H, 1024, W + WO_IN, 1024, 256, 8);
      gemm_phase<EPI_XKV>(p, smem, (const bf16_t*)(p.ws + OFF_SM), 1024, W + WO_XKV, 1024, 4, 16, 0);
      break;
    case 1: phase_rows_mla(p, l); break;
    case 2:
      gemm_phase<EPI_QUP>(p, smem, (const bf16_t*)(p.ws + OFF_Y), 384, W + WO_QUP, 256, 256, 3, 1);
      gemm_phase<EPI_KVUP>(p, smem, (const bf16_t*)(p.ws + OFF_Y) + 256, 384, W + WO_KVUP, 128, 256, 4, 1);
      break;
    case 3: phase_attn(p, l, smem); break;
    case 4: gemm_phase_g<EPI_F32>(p, smem, BIG + (size_t)64 * MiB, 1024, W + WO_OUT, 1024, 256, 4); break;
    case 5: phase_rows_res(p, l == 0 ? p.x_in : p.xres, p.g_mix_post + l * 1024, p.g_x_pre + l * 1024); break;
    case 6: gemm_phase_g<EPI_XQ>(p, smem, H, 1024, W + WO_XQ, 1024, 256, 4); break;
    case 7: phase_xattn(p, smem); break;
    case 8: gemm_phase_g<EPI_F32>(p, smem, BIG + (size_t)32 * MiB, 1024, W + WO_XO, 1024, 256, 4); break;
    case 9: phase_rows_res(p, p.xres, p.g_x_post + l * 1024, p.g_ffn_pre + l * 1024); break;
    case 10: gemm_phase_g<EPI_SWIGLU>(p, smem, H, 1024, W + WO_FI, 1024, 256, 22); break;
    case 11: gemm_phase_g<EPI_F32>(p, smem, BIG, DFF, W + WO_FO, DFF, 256, 4); break;
    case 12: phase_rows_init_or_res3(p, l, false, smem); break;
  }
}

constexpr int NPHASES = 1 + 13 * DEPTH;

__global__ void __launch_bounds__(NTHREADS, 2) fwd_megakernel(Params p) {
  __shared__ __attribute__((aligned(16))) char smem[SMEM_BYTES];
  __shared__ uint4 xb_words;
  cg::grid_group grid = cg::this_grid();
  if (threadIdx.x == 0) xb_words = make_uint4(0u, 0u, 0u, 0u);
  __syncthreads();
  XcdBarrier xb = xcd_barrier_post((unsigned*)(p.ws + OFF_BAR), (volatile LAS unsigned*)&xb_words);
  for (int ph = p.phase_begin; ph < p.phase_end; ++ph) {
    {
#if defined(__HIP_DEVICE_COMPILE__)
      typedef const Params __attribute__((address_space(4)))* KargPtr;
      KargPtr pp = (KargPtr)__builtin_amdgcn_kernarg_segment_ptr();
      asm volatile("" : "+s"(pp));
      const Params q = *pp;
#else
      const Params q = p;
#endif
      run_phase(q, ph, smem);
#if PROBE_DUP
      if (ph > 0 && ((PROBE_DUP >> ((ph - 1) % 13)) & 1)) { __syncthreads(); run_phase(q, ph, smem); }
#endif
    }
    if (ph + 1 < p.phase_end) {
      if (ph == p.phase_begin) grid.sync();
      else xcd_barrier(xb);
    }
  }
}

extern "C" void kernel_launch(void* const* d_in, const int* in_sizes, int n_in, void* d_out, int out_size, void* d_ws, size_t ws_size,
                              hipStream_t stream) {
  static int grid_blocks = 0;
  if (!grid_blocks) {
    int dev = 0, cus = 0, per_cu = 0;
    hipGetDevice(&dev);
    hipDeviceGetAttribute(&cus, hipDeviceAttributeMultiprocessorCount, dev);
    hipOccupancyMaxActiveBlocksPerMultiprocessor(&per_cu, fwd_megakernel, NTHREADS, 0);
    if (per_cu > 2) per_cu = 2;
    if (per_cu < 1) per_cu = 1;
    grid_blocks = cus * per_cu;
    grid_blocks &= ~7;
  }
  Params p{};
  p.x_in = (const float*)d_in[0]; p.mem = (const float*)d_in[1]; p.pos = (const int*)d_in[2];
  p.g_mix_pre = (const float*)d_in[3]; p.g_mix_post = (const float*)d_in[4]; p.w_in = (const float*)d_in[5];
  p.diff_lambda = (const float*)d_in[6]; p.diff_head_g = (const float*)d_in[7]; p.mla_q_norm_g = (const float*)d_in[8];
  p.mla_w_q_up = (const float*)d_in[9]; p.mla_kv_norm_g = (const float*)d_in[10]; p.mla_w_kv_up = (const float*)d_in[11];
  p.swa_sinks = (const float*)d_in[12]; p.w_out = (const float*)d_in[13]; p.g_x_pre = (const float*)d_in[14];
  p.g_x_mem = (const float*)d_in[15]; p.g_x_post = (const float*)d_in[16]; p.w_xq = (const float*)d_in[17];
  p.w_xkv = (const float*)d_in[18]; p.w_xo = (const float*)d_in[19]; p.g_ffn_pre = (const float*)d_in[20];
  p.g_ffn_post = (const float*)d_in[21]; p.w_ffn_in = (const float*)d_in[22]; p.w_ffn_out = (const float*)d_in[23];
  p.xres = (float*)d_out; p.ws = (char*)d_ws;
#if SINGLE_LAUNCH
  hipMemsetAsync((char*)d_ws + OFF_BAR, 0, XCD_BAR_WORDS * sizeof(unsigned), stream);
  p.phase_begin = 0; p.phase_end = NPHASES;
  void* args[] = {&p};
  hipError_t e = hipLaunchCooperativeKernel((void*)fwd_megakernel, dim3(grid_blocks), dim3(NTHREADS), args, 0, stream);
  if (e != hipSuccess) fprintf(stderr, "cooperative launch failed: %s (grid %d)\n", hipGetErrorString(e), grid_blocks);
#else
  for (int ph = 0; ph < NPHASES; ++ph) {
    p.phase_begin = ph; p.phase_end = ph + 1;
    fwd_megakernel<<<dim3(grid_blocks), dim3(NTHREADS), 0, stream>>>(p);
  }
#endif
}
```

```cpp
#include <hip/hip_runtime.h>
#include <hip/hip_cooperative_groups.h>
#include <stdint.h>
#include <stdio.h>
namespace cg = cooperative_groups;

#ifndef SINGLE_LAUNCH
#define SINGLE_LAUNCH 1
#endif

#ifndef PROBE_DUP
#define PROBE_DUP 0
#endif
#ifndef ATT_SEL
#define ATT_SEL 7
#endif
#define DI __device__ __forceinline__
typedef unsigned short bf16_t;
typedef __attribute__((ext_vector_type(8))) short bf16x8;
typedef __attribute__((ext_vector_type(16))) float f32x16;
typedef __bf16 bf16x2_t __attribute__((ext_vector_type(2)));
typedef float f32x2_t __attribute__((ext_vector_type(2)));
typedef uint32_t u32x4 __attribute__((ext_vector_type(4)));
typedef uint32_t u32x2 __attribute__((ext_vector_type(2)));
typedef float f32x4 __attribute__((ext_vector_type(4)));

constexpr int SEQ = 16384, NTOK = 32768, DM = 1024, DFF = 2816, DIN = 1952, DEPTH = 4;
constexpr float LOG2E = 1.4426950408889634f;
constexpr float EPSN = 1e-6f;
constexpr int NTHREADS = 256;
constexpr int SMEM_BYTES = 73728;

constexpr size_t MiB = 1ull << 20;
constexpr size_t OFF_W = 0, OFF_H = 33 * MiB, OFF_Y = 97 * MiB, OFF_BIG = 225 * MiB, OFF_SM = 417 * MiB, OFF_BAR = 421 * MiB;
constexpr size_t WO_IN = 0;
constexpr size_t WO_QUP = WO_IN + 2048 * 1024;
constexpr size_t WO_KVUP = WO_QUP + 384 * 256;
constexpr size_t WO_OUT = WO_KVUP + 512 * 128;
constexpr size_t WO_XQ = WO_OUT + 1024 * 1024;
constexpr size_t WO_XKV = WO_XQ + 1024 * 1024;
constexpr size_t WO_XO = WO_XKV + 2048 * 1024;
constexpr size_t WO_FI = WO_XO + 1024 * 1024;
constexpr size_t WO_FO = WO_FI + 5632 * 1024;

struct Params {
  const float* x_in; const float* mem; const int* pos;
  const float* g_mix_pre; const float* g_mix_post; const float* w_in; const float* diff_lambda; const float* diff_head_g;
  const float* mla_q_norm_g; const float* mla_w_q_up; const float* mla_kv_norm_g; const float* mla_w_kv_up;
  const float* swa_sinks; const float* w_out; const float* g_x_pre; const float* g_x_mem; const float* g_x_post;
  const float* w_xq; const float* w_xkv; const float* w_xo; const float* g_ffn_pre; const float* g_ffn_post;
  const float* w_ffn_in; const float* w_ffn_out;
  float* xres;
  char* ws;
  int phase_begin, phase_end, pad0, pad1;
};

DI uint32_t pack2(float a, float b) { f32x2_t v = {a, b}; bf16x2_t r = __builtin_convertvector(v, bf16x2_t); return __builtin_bit_cast(uint32_t, r); }
DI bf16_t tobf(float a) { return (bf16_t)(pack2(a, 0.f) & 0xffffu); }
DI float frombf(uint32_t v) { return __uint_as_float(v << 16); }
DI f32x16 mfma32(bf16x8 a, bf16x8 b, f32x16 c) { return __builtin_amdgcn_mfma_f32_32x32x16_bf16(a, b, c, 0, 0, 0); }
DI int opaque_tid() { int t = threadIdx.x; asm volatile("" : "+v"(t)); return t; }
DI float fexp2(float x) { return __builtin_amdgcn_exp2f(x); }
DI float wave_sum(float v) {
#pragma unroll
  for (int o = 32; o >= 1; o >>= 1) v += __shfl_xor(v, o);
  return v;
}
DI float half_max(float v) {
  auto r = __builtin_amdgcn_permlane32_swap(__float_as_uint(v), __float_as_uint(v), false, false);
  return fmaxf(__uint_as_float(r[0]), __uint_as_float(r[1]));
}
DI float rope_inv(int i) { return exp2f(-(float)i * 0.8304820237218406f); }
DI void sincos_red(float ang, float& s, float& c) {
  double a = (double)ang;
  double k = rint(a * 0.15915494309189535);
  float r = (float)(a - k * 6.283185307179586);
  s = sinf(r); c = cosf(r);
}
DI void store_vt(bf16_t* rowbase, int tok32, int g, int h, float v0, float v1, float v2, float v3) {
  int pos = tok32 + 16 * (g >> 1) + 8 * h + 4 * (g & 1);
  uint2 u; u.x = pack2(v0, v1); u.y = pack2(v2, v3);
  *(uint2*)(rowbase + pos) = u;
}


#define XB_TMO      128
#define XB_XCNT(j)  (256  + 64 * (j))
#define XB_XSUB(j)  (1280 + 64 * (j))
#define XB_XGEN(j)  (2304 + 64 * (j))
#define XB_TOP      3328
#define XB_TOPGEN   3392
#define XCD_BAR_WORDS 3456
#define XB_SPIN_CAP (1u << 22)
#define LAS __attribute__((address_space(3)))
DI unsigned xb_ld(unsigned* p)              { return __hip_atomic_load(p, __ATOMIC_RELAXED, __HIP_MEMORY_SCOPE_AGENT); }
DI unsigned xb_add(unsigned* p, unsigned v) { return __hip_atomic_fetch_add(p, v, __ATOMIC_RELAXED, __HIP_MEMORY_SCOPE_AGENT); }
DI unsigned xb_xcc_id() { return (unsigned)__builtin_amdgcn_s_getreg((3 << 11) | 20) & 0xFu; }
#define XB_SPIN(cond, bar) do { unsigned _sp = 0; while (cond) { __builtin_amdgcn_s_sleep(1); \
    if ((++_sp & 255u) == 0u) { if (xb_ld(&(bar)[XB_TMO])) break; if (_sp > XB_SPIN_CAP) { atomicAdd(&(bar)[XB_TMO], 1u); break; } } } } while (0)
struct XcdBarrier { unsigned* bar; unsigned x; volatile LAS unsigned* st; };
DI XcdBarrier xcd_barrier_post(unsigned* bar, volatile LAS unsigned* st) {
  XcdBarrier b; b.bar = bar; b.x = xb_xcc_id(); b.st = st;
  if (threadIdx.x == 0) (void)xb_add(&bar[XB_XCNT(b.x)], 1u);
  return b;
}
DI void xcd_barrier_complete(unsigned* bar, unsigned x, unsigned& nloc, unsigned& nx) {
  const unsigned G = gridDim.x * gridDim.y * gridDim.z;
  unsigned sum, cnt, mine, sp = 0u;
  for (;;) {
    sum = 0u; cnt = 0u; mine = 0u;
#pragma unroll
    for (unsigned j = 0; j < 16; ++j) { const unsigned c = xb_ld(&bar[XB_XCNT(j)]); sum += c; cnt += (c > 0u) ? 1u : 0u; mine = (j == x) ? c : mine; }
    if (sum == G) break;
    __builtin_amdgcn_s_sleep(1);
    if ((++sp & 255u) == 0u) { if (xb_ld(&bar[XB_TMO])) break; if (sp > XB_SPIN_CAP) { atomicAdd(&bar[XB_TMO], 1u); break; } }
  }
  nloc = mine > 0u ? mine : 1u; nx = cnt > 0u ? cnt : 1u;
}
DI void xcd_barrier(const XcdBarrier& b) {
  asm volatile("s_waitcnt vmcnt(0)" ::: "memory");
  __syncthreads();
  if (threadIdx.x == 0) {
    unsigned* bar = b.bar;
    __builtin_amdgcn_s_waitcnt(0);
    unsigned nloc = b.st[0], nx = b.st[1];
    if (nloc == 0u) { xcd_barrier_complete(bar, b.x, nloc, nx); b.st[0] = nloc; b.st[1] = nx; }
    const unsigned old = xb_add(&bar[XB_XSUB(b.x)], 1u);
    const unsigned gen = old / nloc;
    if (old + 1u == (gen + 1u) * nloc) {
      __builtin_amdgcn_fence(__ATOMIC_RELEASE, "agent");
      asm volatile("s_waitcnt vmcnt(0)" ::: "memory");
      const unsigned og = xb_add(&bar[XB_TOP], 1u);
      const unsigned tg = og / nx;
      if (og + 1u == (tg + 1u) * nx) xb_add(&bar[XB_TOPGEN], 1u);
      else XB_SPIN(xb_ld(&bar[XB_TOPGEN]) == tg, bar);
      __builtin_amdgcn_fence(__ATOMIC_ACQUIRE, "agent");
      xb_add(&bar[XB_XGEN(b.x)], 1u);
      asm volatile("s_waitcnt vmcnt(0)" ::: "memory");
    } else {
      XB_SPIN(xb_ld(&bar[XB_XGEN(b.x)]) == gen, bar);
      __builtin_amdgcn_fence(__ATOMIC_ACQUIRE, "agent");
      asm volatile("s_waitcnt vmcnt(0)" ::: "memory");
    }
  }
  __syncthreads();
}

DI void convert_weights(const Params& p, int l, char* smem) {
  const int tid = opaque_tid();
  bf16_t* W = (bf16_t*)(p.ws + OFF_W);
  float* tile = (float*)smem;
  for (int t = blockIdx.x; t < 7840; t += gridDim.x) {
    const float* src; int K, N, lt, mode = 0; bf16_t* dst;
    if (t < 976)       { src = p.w_in + (size_t)l * 1024 * 1952;      K = 1024; N = 1952; dst = W + WO_IN;   lt = t; }
    else if (t < 1024) { src = p.mla_w_q_up + (size_t)l * 256 * 384;  K = 256;  N = 384;  dst = W + WO_QUP;  lt = t - 976; }
    else if (t < 1056) { src = p.mla_w_kv_up + (size_t)l * 128 * 512; K = 128;  N = 512;  dst = W + WO_KVUP; lt = t - 1024; }
    else if (t < 1568) { src = p.w_out + (size_t)l * 1024 * 1024;     K = 1024; N = 1024; dst = W + WO_OUT;  lt = t - 1056; }
    else if (t < 2080) { src = p.w_xq + (size_t)l * 1024 * 1024;      K = 1024; N = 1024; dst = W + WO_XQ;   lt = t - 1568; }
    else if (t < 3104) { src = p.w_xkv + (size_t)l * 1024 * 2048;     K = 1024; N = 2048; dst = W + WO_XKV;  lt = t - 2080; }
    else if (t < 3616) { src = p.w_xo + (size_t)l * 1024 * 1024;      K = 1024; N = 1024; dst = W + WO_XO;   lt = t - 3104; }
    else if (t < 6432) { src = p.w_ffn_in + (size_t)l * 1024 * 5632;  K = 1024; N = 5632; dst = W + WO_FI;   lt = t - 3616; mode = 1; }
    else               { src = p.w_ffn_out + (size_t)l * 2816 * 1024; K = 2816; N = 1024; dst = W + WO_FO;   lt = t - 6432; }
    const int nNt = N >> 5;
    const int k0 = (lt / nNt) * 64, n0 = (lt % nNt) * 32;
#pragma unroll
    for (int it = 0; it < 2; ++it) {
      const int c = tid + 256 * it, i = c >> 3, j4 = (c & 7) * 4;
      const float4 v = *(const float4*)(src + (size_t)(k0 + i) * N + n0 + j4);
      tile[i * 33 + j4] = v.x; tile[i * 33 + j4 + 1] = v.y; tile[i * 33 + j4 + 2] = v.z; tile[i * 33 + j4 + 3] = v.w;
    }
    __syncthreads();
    {
      const int jn = tid & 31, kg = (tid >> 5) * 8;
      u32x4 o;
      o[0] = pack2(tile[(kg + 0) * 33 + jn], tile[(kg + 1) * 33 + jn]);
      o[1] = pack2(tile[(kg + 2) * 33 + jn], tile[(kg + 3) * 33 + jn]);
      o[2] = pack2(tile[(kg + 4) * 33 + jn], tile[(kg + 5) * 33 + jn]);
      o[3] = pack2(tile[(kg + 6) * 33 + jn], tile[(kg + 7) * 33 + jn]);
      int n = n0 + jn, drow = n;
      if (mode == 1) drow = (n < DFF) ? ((n >> 5) * 64 + (n & 31)) : ((((n - DFF) >> 5) * 64) + 32 + ((n - DFF) & 31));
      *(u32x4*)(dst + (size_t)drow * K + k0 + kg) = o;
    }
    __syncthreads();
  }
  uint32_t* padp = (uint32_t*)(W + WO_IN + (size_t)1952 * 1024);
  for (int i = blockIdx.x * NTHREADS + tid; i < 49152; i += gridDim.x * NTHREADS) padp[i] = 0u;
}

template <bool RES, bool NORM2>
DI void row_op(const float* xsrc, const bf16_t* Yrow, const float* gpost, float* xdst, const float* gnext, bf16_t* Hout, int lane) {
  float4 xv[4];
#pragma unroll
  for (int j = 0; j < 4; ++j) { const f32x4 t_ = __builtin_nontemporal_load((const f32x4*)(xsrc + j * 256 + lane * 4)); xv[j].x = t_[0]; xv[j].y = t_[1]; xv[j].z = t_[2]; xv[j].w = t_[3]; }
  if (RES) {
    float4 yv[4]; float ss = 0.f;
#pragma unroll
    for (int j = 0; j < 4; ++j) {
      const u32x2 yt_ = __builtin_nontemporal_load((const u32x2*)(Yrow + j * 256 + lane * 4)); uint2 yu; yu.x = yt_[0]; yu.y = yt_[1];
      yv[j].x = frombf(yu.x & 0xffffu); yv[j].y = frombf(yu.x >> 16); yv[j].z = frombf(yu.y & 0xffffu); yv[j].w = frombf(yu.y >> 16);
      ss += yv[j].x * yv[j].x + yv[j].y * yv[j].y + yv[j].z * yv[j].z + yv[j].w * yv[j].w;
    }
    ss = wave_sum(ss);
    float rs = rsqrtf(ss * (1.f / 1024.f) + EPSN);
#pragma unroll
    for (int j = 0; j < 4; ++j) {
      float4 g = *(const float4*)(gpost + j * 256 + lane * 4);
      xv[j].x += yv[j].x * rs * g.x; xv[j].y += yv[j].y * rs * g.y; xv[j].z += yv[j].z * rs * g.z; xv[j].w += yv[j].w * rs * g.w;
      { f32x4 t_; t_[0] = xv[j].x; t_[1] = xv[j].y; t_[2] = xv[j].z; t_[3] = xv[j].w; __builtin_nontemporal_store(t_, (f32x4*)(xdst + j * 256 + lane * 4)); }
    }
  }
  if (NORM2) {
    float ss = 0.f;
#pragma unroll
    for (int j = 0; j < 4; ++j) ss += xv[j].x * xv[j].x + xv[j].y * xv[j].y + xv[j].z * xv[j].z + xv[j].w * xv[j].w;
    ss = wave_sum(ss);
    float rs = rsqrtf(ss * (1.f / 1024.f) + EPSN);
#pragma unroll
    for (int j = 0; j < 4; ++j) {
      float4 g = *(const float4*)(gnext + j * 256 + lane * 4);
      uint2 u; u.x = pack2(xv[j].x * rs * g.x, xv[j].y * rs * g.y); u.y = pack2(xv[j].z * rs * g.z, xv[j].w * rs * g.w);
      *(uint2*)(Hout + j * 256 + lane * 4) = u;
    }
  }
}

enum { EPI_F32 = 0, EPI_PROJ, EPI_XKV, EPI_QUP, EPI_KVUP, EPI_XQ, EPI_SWIGLU };

template <int EPI, int NB>
DI void gemm_epilogue(const Params& p, const f32x16 (&acc)[2][NB], int m0, int n0, int wm, int wn, int l31, int h) {
  bf16_t* PROJ = (bf16_t*)(p.ws + OFF_BIG);
#pragma unroll
  for (int i = 0; i < 2; ++i) {
    const int rb = m0 + wm * 64 + i * 32;
#pragma unroll
    for (int jn = 0; jn < NB; ++jn) {
      const int cb = n0 + wn * (32 * NB) + jn * 32;
      const int col = cb + l31;
      if (EPI == EPI_F32) {
        bf16_t* Y = (bf16_t*)(p.ws + OFF_Y);
#pragma unroll
        for (int r = 0; r < 16; ++r) { int row = rb + 8 * (r >> 2) + 4 * h + (r & 3); Y[(size_t)row * 1024 + col] = tobf(acc[i][jn][r]); }
      } else if (EPI == EPI_XQ) {
        const float sc = LOG2E * 0.0625f;
#pragma unroll
        for (int r = 0; r < 16; ++r) { int row = rb + 8 * (r >> 2) + 4 * h + (r & 3); PROJ[(size_t)row * 1024 + col] = tobf(acc[i][jn][r] * sc); }
      } else if (EPI == EPI_PROJ) {
        if (cb >= DIN) continue;
        if (cb >= 512 && cb < 768) {
          bf16_t* VtA = (bf16_t*)(p.ws + OFF_Y + 72 * MiB);
          int c2 = col - 512; int b = rb / SEQ, tok32 = rb % SEQ;
          bf16_t* rowp = VtA + ((size_t)(b * 4 + (c2 >> 6)) * 64 + (c2 & 63)) * SEQ;
#pragma unroll
          for (int g = 0; g < 4; ++g) store_vt(rowp, tok32, g, h, acc[i][jn][4 * g], acc[i][jn][4 * g + 1], acc[i][jn][4 * g + 2], acc[i][jn][4 * g + 3]);
        } else if (cb >= 1824) {
          bf16_t* VtC = (bf16_t*)(p.ws + OFF_Y + 104 * MiB);
          int c2 = col - 1824; int b = rb / SEQ, tok32 = rb % SEQ;
          bf16_t* rowp = VtC + ((size_t)(b * 2 + (c2 >> 6)) * 64 + (c2 & 63)) * SEQ;
#pragma unroll
          for (int g = 0; g < 4; ++g) store_vt(rowp, tok32, g, h, acc[i][jn][4 * g], acc[i][jn][4 * g + 1], acc[i][jn][4 * g + 2], acc[i][jn][4 * g + 3]);
        } else {
          float sc = 1.f;
          if (cb < 256) sc = LOG2E * 0.17677669529663687f;
          else if (cb >= 1184 && cb < 1696) sc = LOG2E * 0.125f;
#pragma unroll
          for (int r = 0; r < 16; ++r) { int row = rb + 8 * (r >> 2) + 4 * h + (r & 3); PROJ[(size_t)row * 2048 + col] = tobf(acc[i][jn][r] * sc); }
        }
      } else if (EPI == EPI_XKV) {
        if (cb < 1024) {
          bf16_t* KX = (bf16_t*)(p.ws + OFF_SM + 1 * MiB);
#pragma unroll
          for (int r = 0; r < 16; ++r) { int row = rb + 8 * (r >> 2) + 4 * h + (r & 3); KX[(size_t)row * 1024 + col] = tobf(acc[i][jn][r]); }
        } else {
          bf16_t* VtX = (bf16_t*)(p.ws + OFF_SM + 2 * MiB);
          int c2 = col - 1024; int b = rb >> 8, tok32 = rb & 255;
          bf16_t* rowp = VtX + ((size_t)(b * 4 + (c2 >> 8)) * 256 + (c2 & 255)) * 256;
#pragma unroll
          for (int g = 0; g < 4; ++g) store_vt(rowp, tok32, g, h, acc[i][jn][4 * g], acc[i][jn][4 * g + 1], acc[i][jn][4 * g + 2], acc[i][jn][4 * g + 3]);
        }
      } else if (EPI == EPI_QUP) {
        bf16_t* QB = (bf16_t*)(p.ws + OFF_Y + 24 * MiB);
        const float sc = LOG2E * 0.10206207261596575f;
        const bool ropeblk = (cb % 96) == 64;
        const float inv = rope_inv(l31 & 15);
#pragma unroll
        for (int r = 0; r < 16; ++r) {
          int row = rb + 8 * (r >> 2) + 4 * h + (r & 3);
          float v = acc[i][jn][r] * sc;
          if (ropeblk) {
            float other = __shfl_xor(v, 16);
            float ang = (float)p.pos[row] * inv;
            float s, c; sincos_red(ang, s, c);
            v = (l31 < 16) ? (v * c - other * s) : (other * s + v * c);
          }
          QB[(size_t)row * 384 + col] = tobf(v);
        }
      } else if (EPI == EPI_KVUP) {
        int head = cb >> 7, within = cb & 127;
        if (within < 64) {
          bf16_t* KB = (bf16_t*)(p.ws + OFF_Y + 48 * MiB);
#pragma unroll
          for (int r = 0; r < 16; ++r) { int row = rb + 8 * (r >> 2) + 4 * h + (r & 3); KB[(size_t)row * 384 + head * 96 + within + l31] = tobf(acc[i][jn][r]); }
        } else {
          bf16_t* VtB = (bf16_t*)(p.ws + OFF_Y + 88 * MiB);
          int dv = within - 64 + l31; int b = rb / SEQ, tok32 = rb % SEQ;
          bf16_t* rowp = VtB + ((size_t)(b * 4 + head) * 64 + dv) * SEQ;
#pragma unroll
          for (int g = 0; g < 4; ++g) store_vt(rowp, tok32, g, h, acc[i][jn][4 * g], acc[i][jn][4 * g + 1], acc[i][jn][4 * g + 2], acc[i][jn][4 * g + 3]);
        }
      } else if (EPI == EPI_SWIGLU) {
        if ((jn & 1) == 0) {
          bf16_t* F = (bf16_t*)(p.ws + OFF_BIG);
          const int oc = (cb >> 1) + l31;
#pragma unroll
          for (int r = 0; r < 16; ++r) {
            int row = rb + 8 * (r >> 2) + 4 * h + (r & 3);
            float g = acc[i][jn][r], u = acc[i][jn + 1 < NB ? jn + 1 : jn][r];
            float sg = g / (1.f + fexp2(-g * LOG2E));
            F[(size_t)row * DFF + oc] = tobf(sg * u);
          }
        }
      }
    }
  }
}

template <int EPI>
DI void gemm_phase(const Params& p, char* smem, const bf16_t* A, int lda, const bf16_t* Wt, int K, int nM, int nN, int xcdmap) {
  const int tid = opaque_tid(), lane = tid & 63, w = tid >> 6, l31 = lane & 31, h = lane >> 5;
  const int wm = w >> 1, wn = w & 1;
  bf16_t* sm = (bf16_t*)smem;
  constexpr int LDSROW = 72;
  constexpr int BUFE = 256 * LDSROW;
  const int nk = K >> 6;
  int total, start, step;
  const int xcd = blockIdx.x & 7;
  if (xcdmap) { total = (nM >> 3) * nN; start = blockIdx.x >> 3; step = gridDim.x >> 3; }
  else { total = nM * nN; start = blockIdx.x; step = gridDim.x; }
  for (int j = start; j < total; j += step) {
    int mt, nt;
    if (xcdmap) { int g = j / (8 * nN), r = j % (8 * nN); nt = r >> 3; mt = xcd * (nM >> 3) + g * 8 + (r & 7); }
    else { mt = j / nN; nt = j % nN; }
    const int m0 = mt * 128, n0 = nt * 128;
    const bf16_t* Ag = A + (size_t)m0 * lda;
    const bf16_t* Bg = Wt + (size_t)n0 * K;
    f32x16 acc[2][2];
#pragma unroll
    for (int i = 0; i < 2; ++i)
#pragma unroll
      for (int jn = 0; jn < 2; ++jn)
#pragma unroll
        for (int r = 0; r < 16; ++r) acc[i][jn][r] = 0.f;
    u32x4 ra0[4], rb0[4], ra1[4], rb1[4];
#define G_LOAD(RA, RB, kt_) do { _Pragma("unroll") for (int i_ = 0; i_ < 4; ++i_) { int c_ = tid + 256 * i_, row_ = c_ >> 3, ch_ = c_ & 7; \
      RA[i_] = *(const u32x4*)(Ag + (size_t)row_ * lda + (kt_) * 64 + ch_ * 8); RB[i_] = *(const u32x4*)(Bg + (size_t)row_ * K + (kt_) * 64 + ch_ * 8); } } while (0)
#define G_STORE(RA, RB, buf_) do { bf16_t* d_ = sm + (buf_) * BUFE; _Pragma("unroll") for (int i_ = 0; i_ < 4; ++i_) { int c_ = tid + 256 * i_, row_ = c_ >> 3, ch_ = c_ & 7; \
      *(u32x4*)(d_ + row_ * LDSROW + ch_ * 8) = RA[i_]; *(u32x4*)(d_ + (128 + row_) * LDSROW + ch_ * 8) = RB[i_]; } } while (0)
#define G_COMPUTE(buf_) do { const bf16_t* As_ = sm + (buf_) * BUFE; const bf16_t* Bs_ = As_ + 128 * LDSROW; \
      _Pragma("unroll") for (int ks_ = 0; ks_ < 4; ++ks_) { \
        bf16x8 a0_ = *(const bf16x8*)(As_ + (wm * 64 + l31) * LDSROW + ks_ * 16 + 8 * h); \
        bf16x8 a1_ = *(const bf16x8*)(As_ + (wm * 64 + 32 + l31) * LDSROW + ks_ * 16 + 8 * h); \
        bf16x8 b0_ = *(const bf16x8*)(Bs_ + (wn * 64 + l31) * LDSROW + ks_ * 16 + 8 * h); \
        bf16x8 b1_ = *(const bf16x8*)(Bs_ + (wn * 64 + 32 + l31) * LDSROW + ks_ * 16 + 8 * h); \
        acc[0][0] = mfma32(a0_, b0_, acc[0][0]); acc[0][1] = mfma32(a0_, b1_, acc[0][1]); \
        acc[1][0] = mfma32(a1_, b0_, acc[1][0]); acc[1][1] = mfma32(a1_, b1_, acc[1][1]); } } while (0)
    G_LOAD(ra0, rb0, 0);
    G_STORE(ra0, rb0, 0);
    G_LOAD(ra0, rb0, 1);
    if (nk > 2) G_LOAD(ra1, rb1, 2);
    __syncthreads();
    for (int kt = 0; kt < nk; kt += 2) {
      G_COMPUTE(0);
      G_STORE(ra0, rb0, 1);
      if (kt + 3 < nk) G_LOAD(ra0, rb0, kt + 3);
      __syncthreads();
      G_COMPUTE(1);
      if (kt + 2 < nk) G_STORE(ra1, rb1, 0);
      if (kt + 4 < nk) G_LOAD(ra1, rb1, kt + 4);
      __syncthreads();
    }
#undef G_LOAD
#undef G_STORE
#undef G_COMPUTE
    gemm_epilogue<EPI, 2>(p, acc, m0, n0, wm, wn, l31, h);
  }
}

template <int EPI>
DI void gemm_phase_w(const Params& p, char* smem, const bf16_t* A, int lda, const bf16_t* Wt, int K, int nM, int nN) {
  const int tid = opaque_tid(), lane = tid & 63, w = tid >> 6, l31 = lane & 31, h = lane >> 5;
  const int wm = w >> 1, wn = w & 1;
  bf16_t* sm = (bf16_t*)smem;
  constexpr int LR = 40;
  constexpr int BUFE = 384 * LR;
  const int nk = K >> 5;
  const int xcd = blockIdx.x & 7;
  const int total = (nM >> 3) * nN, start = blockIdx.x >> 3, step = gridDim.x >> 3;
  for (int j = start; j < total; j += step) {
    const int g = j / (8 * nN), r8 = j % (8 * nN);
    const int nt = r8 >> 3, mt = xcd * (nM >> 3) + g * 8 + (r8 & 7);
    const int m0 = mt * 128, n0 = nt * 256;
    const bf16_t* Ag = A + (size_t)m0 * lda;
    const bf16_t* Bg = Wt + (size_t)n0 * K;
    f32x16 acc[2][4];
#pragma unroll
    for (int i = 0; i < 2; ++i)
#pragma unroll
      for (int jn = 0; jn < 4; ++jn)
#pragma unroll
        for (int r = 0; r < 16; ++r) acc[i][jn][r] = 0.f;
    u32x4 ra[2], rb[4];
#define W_LOAD(kt_) do { \
      _Pragma("unroll") for (int i_ = 0; i_ < 2; ++i_) { int c_ = tid + 256 * i_, row_ = c_ >> 2, ch_ = c_ & 3; ra[i_] = *(const u32x4*)(Ag + (size_t)row_ * lda + (kt_) * 32 + ch_ * 8); } \
      _Pragma("unroll") for (int i_ = 0; i_ < 4; ++i_) { int c_ = tid + 256 * i_, row_ = c_ >> 2, ch_ = c_ & 3; rb[i_] = *(const u32x4*)(Bg + (size_t)row_ * K + (kt_) * 32 + ch_ * 8); } } while (0)
#define W_STORE(buf_) do { bf16_t* d_ = sm + (buf_) * BUFE; \
      _Pragma("unroll") for (int i_ = 0; i_ < 2; ++i_) { int c_ = tid + 256 * i_, row_ = c_ >> 2, ch_ = c_ & 3; *(u32x4*)(d_ + row_ * LR + ch_ * 8) = ra[i_]; } \
      _Pragma("unroll") for (int i_ = 0; i_ < 4; ++i_) { int c_ = tid + 256 * i_, row_ = c_ >> 2, ch_ = c_ & 3; *(u32x4*)(d_ + (128 + row_) * LR + ch_ * 8) = rb[i_]; } } while (0)
    W_LOAD(0); W_STORE(0);
    __syncthreads();
    for (int kt = 0; kt < nk; ++kt) {
      const bool more = (kt + 1 < nk);
      if (more) W_LOAD(kt + 1);
      const bf16_t* As = sm + (kt & 1) * BUFE;
      const bf16_t* Bs = As + 128 * LR;
#pragma unroll
      for (int ks = 0; ks < 2; ++ks) {
        bf16x8 a0 = *(const bf16x8*)(As + (wm * 64 + l31) * LR + ks * 16 + 8 * h);
        bf16x8 a1 = *(const bf16x8*)(As + (wm * 64 + 32 + l31) * LR + ks * 16 + 8 * h);
#pragma unroll
        for (int jn = 0; jn < 4; ++jn) {
          bf16x8 b = *(const bf16x8*)(Bs + (wn * 128 + jn * 32 + l31) * LR + ks * 16 + 8 * h);
          acc[0][jn] = mfma32(a0, b, acc[0][jn]);
          acc[1][jn] = mfma32(a1, b, acc[1][jn]);
        }
      }
      if (more) W_STORE((kt + 1) & 1);
      __syncthreads();
    }
#undef W_LOAD
#undef W_STORE
    gemm_epilogue<EPI, 4>(p, acc, m0, n0, wm, wn, l31, h);
  }
}

#define RAW_BARRIER() do { asm volatile("s_waitcnt lgkmcnt(0)" ::: "memory"); __builtin_amdgcn_s_barrier(); } while (0)
typedef __attribute__((address_space(3))) unsigned lds_u32;
template <int EPI>
DI void gemm_phase_g(const Params& p, char* smem, const bf16_t* A, int lda, const bf16_t* Wt, int K, int nM, int nN) {
  const int tid = opaque_tid(), lane = tid & 63, w = tid >> 6, l31 = lane & 31, h = lane >> 5;
  const int wm = w >> 1, wn = w & 1;
  constexpr int STAGE = 24576;
  const int nk = K >> 5;
  const int xcd = blockIdx.x & 7;
  const int total = (nM >> 3) * nN, start = blockIdx.x >> 3, step = gridDim.x >> 3;
  const int rip = lane >> 2, gch = (lane & 3) ^ ((lane >> 4) & 3);
  const int fsw = (l31 >> 2) & 3;
  const int lo0 = (l31 >> 4) * 1024 + (l31 & 15) * 64 + ((h ^ fsw) * 16);
  const int lo1 = (l31 >> 4) * 1024 + (l31 & 15) * 64 + (((2 + h) ^ fsw) * 16);
  const int wuni = __builtin_amdgcn_readfirstlane(w);
  const unsigned ldsA = (unsigned)(size_t)smem + (unsigned)(wm * 4096);
  const unsigned ldsB = (unsigned)(size_t)smem + 8192u + (unsigned)(wn * 8192);
  for (int j = start; j < total; j += step) {
    const int g = j / (8 * nN), r8 = j % (8 * nN);
    const int nt = r8 >> 3, mt = xcd * (nM >> 3) + g * 8 + (r8 & 7);
    const int m0 = mt * 128, n0 = nt * 256;
    const bf16_t* srcA0 = A + (size_t)(m0 + 16 * w + rip) * lda + gch * 8;
    const bf16_t* srcB0 = Wt + (size_t)(n0 + 16 * w + rip) * K + gch * 8;
    f32x16 acc[2][4];
#pragma unroll
    for (int i = 0; i < 2; ++i)
#pragma unroll
      for (int jn = 0; jn < 4; ++jn)
#pragma unroll
        for (int r = 0; r < 16; ++r) acc[i][jn][r] = 0.f;
#define GLDS_STEP(kt_, st_) do { \
      char* sb_ = smem + (st_) * STAGE + wuni * 1024; \
      _Pragma("unroll") for (int i_ = 0; i_ < 2; ++i_) \
        __builtin_amdgcn_global_load_lds((const unsigned*)(srcA0 + (size_t)(64 * i_) * lda + (kt_) * 32), (lds_u32*)(sb_ + i_ * 4096), 16, 0, 0); \
      _Pragma("unroll") for (int i_ = 0; i_ < 4; ++i_) \
        __builtin_amdgcn_global_load_lds((const unsigned*)(srcB0 + (size_t)(64 * i_) * K + (kt_) * 32), (lds_u32*)(sb_ + 8192 + i_ * 4096), 16, 0, 0); \
    } while (0)
    GLDS_STEP(0, 0);
    GLDS_STEP(1, 1);
    int st = 0;
    for (int kt = 0; kt < nk; ++kt) {
      if (kt + 1 < nk) asm volatile("s_waitcnt vmcnt(6)" ::: "memory");
      else asm volatile("s_waitcnt vmcnt(0)" ::: "memory");
      RAW_BARRIER();
      if (kt + 2 < nk) { const int st2 = (st >= 1) ? st - 1 : 2; GLDS_STEP(kt + 2, st2); }
      const unsigned sa = ldsA + st * STAGE, sbb = ldsB + st * STAGE;
      bf16x8 fa0, fa1, fb0, fb1, fb2, fb3, ga0, ga1, gb0, gb1, gb2, gb3;
      asm volatile(
          "ds_read_b128 %0, %12\n\tds_read_b128 %1, %12 offset:2048\n\t"
          "ds_read_b128 %2, %13\n\tds_read_b128 %3, %13 offset:2048\n\tds_read_b128 %4, %13 offset:4096\n\tds_read_b128 %5, %13 offset:6144\n\t"
          "ds_read_b128 %6, %14\n\tds_read_b128 %7, %14 offset:2048\n\t"
          "ds_read_b128 %8, %15\n\tds_read_b128 %9, %15 offset:2048\n\tds_read_b128 %10, %15 offset:4096\n\tds_read_b128 %11, %15 offset:6144\n\t"
          "s_waitcnt lgkmcnt(6)"
          : "=&v"(fa0), "=&v"(fa1), "=&v"(fb0), "=&v"(fb1), "=&v"(fb2), "=&v"(fb3),
            "=&v"(ga0), "=&v"(ga1), "=&v"(gb0), "=&v"(gb1), "=&v"(gb2), "=&v"(gb3)
          : "v"(sa + lo0), "v"(sbb + lo0), "v"(sa + lo1), "v"(sbb + lo1)
          : "memory");
      __builtin_amdgcn_s_setprio(1);
      acc[0][0] = mfma32(fa0, fb0, acc[0][0]); acc[1][0] = mfma32(fa1, fb0, acc[1][0]);
      acc[0][1] = mfma32(fa0, fb1, acc[0][1]); acc[1][1] = mfma32(fa1, fb1, acc[1][1]);
      acc[0][2] = mfma32(fa0, fb2, acc[0][2]); acc[1][2] = mfma32(fa1, fb2, acc[1][2]);
      acc[0][3] = mfma32(fa0, fb3, acc[0][3]); acc[1][3] = mfma32(fa1, fb3, acc[1][3]);
      asm volatile("s_waitcnt lgkmcnt(0)" : "+v"(ga0), "+v"(ga1), "+v"(gb0), "+v"(gb1), "+v"(gb2), "+v"(gb3) : : "memory");
      acc[0][0] = mfma32(ga0, gb0, acc[0][0]); acc[1][0] = mfma32(ga1, gb0, acc[1][0]);
      acc[0][1] = mfma32(ga0, gb1, acc[0][1]); acc[1][1] = mfma32(ga1, gb1, acc[1][1]);
      acc[0][2] = mfma32(ga0, gb2, acc[0][2]); acc[1][2] = mfma32(ga1, gb2, acc[1][2]);
      acc[0][3] = mfma32(ga0, gb3, acc[0][3]); acc[1][3] = mfma32(ga1, gb3, acc[1][3]);
      __builtin_amdgcn_s_setprio(0);
      st = (st == 2) ? 0 : st + 1;
    }
    __syncthreads();
#undef GLDS_STEP
    gemm_epilogue<EPI, 4>(p, acc, m0, n0, wm, wn, l31, h);
  }
}

template <int DQK, int NMAP, int DV, int KIND, bool PREFETCH, bool AUG, bool FAST>
DI void attn_tiles(char* smem, int tid, const bf16_t* Kp, int ldk, const bf16_t* Vt, int ldv, int kt0, int kt1,
                   unsigned long long tm0, unsigned long long tm1, unsigned long long tm2, unsigned long long tm3,
                   const int* posk, const float* pmm, float slope2, float pq, int qidx, float qmin,
                   const bf16x8 (&qf)[NMAP][DQK / 16], bf16x8 qaugP,
                   f32x16 (&O)[NMAP][DV / 32], float (&mrun)[NMAP], float (&lrun)[NMAP]) {
  constexpr bool USEMASK = (KIND == 0);
  constexpr bool LSUM = (KIND == 0) && AUG && FAST;
  constexpr bool SEQM = ((KIND == 1) && FAST);
  constexpr bool QLDS = (KIND == 0);
  constexpr bool POS = (!AUG) && (KIND == 0 || KIND == 2);
  constexpr int KAUG = (KIND == 0) ? 16 : 0;
  constexpr bool KSHARE = (KIND == 1);
  constexpr int KD = KSHARE ? DQK : NMAP * DQK;
  constexpr int KROW = KD + KAUG + 8, VROW = 72;
  constexpr int KBYTES = 64 * KROW * 2, VBYTES = DV * VROW * 2, BUFBYTES = KBYTES + VBYTES + 512;
  constexpr int CH = KD / 8, KCH = CH / 4, VCH = DV / 32;
  constexpr int NKS = DQK / 16, NDB = DV / 32;
  const int lane = tid & 63, l31 = lane & 31, h = lane >> 5;

  u32x4 kreg[KCH], vreg[VCH]; float pkreg = 0.f, kmnreg = 0.f;
#define LOAD_REGS(kt_) do { int tl_ = tid; if (KIND == 1) asm volatile("" : "+v"(tl_));   \
    _Pragma("unroll") for (int i_ = 0; i_ < KCH; ++i_) { int c_ = tl_ + 256 * i_, row_ = c_ / CH, ch_ = c_ % CH; kreg[i_] = *(const u32x4*)(Kp + (size_t)((kt_) * 64 + row_) * ldk + ch_ * 8); } \
    _Pragma("unroll") for (int i_ = 0; i_ < VCH; ++i_) { int c_ = tl_ + 256 * i_, row_ = c_ >> 3, ch_ = c_ & 7; vreg[i_] = *(const u32x4*)(Vt + (size_t)row_ * ldv + (kt_) * 64 + ch_ * 8); } \
    if (POS || AUG) { pkreg = (float)posk[(kt_) * 64 + (tid & 63)]; } \
    if (AUG) { kmnreg = pmm[2 * (kt_)]; } } while (0)
#define COPY_TILE(kt_) do { \
    bf16_t* Ks_ = (bf16_t*)smem; bf16_t* Vs_ = (bf16_t*)(smem + KBYTES); \
    _Pragma("unroll") for (int i0_ = 0; i0_ < KCH; i0_ += 4) { \
      u32x4 t_[4]; \
      _Pragma("unroll") for (int i_ = 0; i_ < 4; ++i_) if (i0_ + i_ < KCH) { int c_ = tid + 256 * (i0_ + i_), row_ = c_ / CH, ch_ = c_ % CH; t_[i_] = *(const u32x4*)(Kp + (size_t)((kt_) * 64 + row_) * ldk + ch_ * 8); } \
      _Pragma("unroll") for (int i_ = 0; i_ < 4; ++i_) if (i0_ + i_ < KCH) { int c_ = tid + 256 * (i0_ + i_), row_ = c_ / CH, ch_ = c_ % CH; *(u32x4*)(Ks_ + row_ * KROW + ch_ * 8) = t_[i_]; } \
      __builtin_amdgcn_sched_barrier(0); } \
    _Pragma("unroll") for (int i_ = 0; i_ < VCH; ++i_) { int c_ = tid + 256 * i_, row_ = c_ >> 3, ch_ = c_ & 7; u32x4 t_ = *(const u32x4*)(Vt + (size_t)row_ * ldv + (kt_) * 64 + ch_ * 8); *(u32x4*)(Vs_ + row_ * VROW + ch_ * 8) = t_; } \
    } while (0)
#define STORE_REGS(buf_) do { int ts_ = tid; if (KIND == 1) asm volatile("" : "+v"(ts_)); \
    char* base_ = smem + (buf_) * BUFBYTES; \
    bf16_t* Ks_ = (bf16_t*)base_; bf16_t* Vs_ = (bf16_t*)(base_ + KBYTES); float* Ps_ = (float*)(base_ + KBYTES + VBYTES); \
    _Pragma("unroll") for (int i_ = 0; i_ < KCH; ++i_) { int c_ = ts_ + 256 * i_, row_ = c_ / CH, ch_ = c_ % CH; *(u32x4*)(Ks_ + row_ * KROW + ch_ * 8) = kreg[i_]; } \
    _Pragma("unroll") for (int i_ = 0; i_ < VCH; ++i_) { int c_ = ts_ + 256 * i_, row_ = c_ >> 3, ch_ = c_ & 7; *(u32x4*)(Vs_ + row_ * VROW + ch_ * 8) = vreg[i_]; } \
    if (POS) { if (tid < 64) Ps_[tid] = pkreg; } \
    if (AUG) { if (tid < 64) { \
        const float b_ = slope2 * (pkreg - kmnreg); const float bh_ = frombf(tobf(b_)), bm_ = frombf(tobf(b_ - bh_)), bl_ = frombf(tobf(b_ - bh_ - bm_)); \
        const float c_ = (kmnreg <= qmin) ? -slope2 * (qmin - kmnreg) : slope2 * (qmin - kmnreg); \
        const float ch_ = frombf(tobf(c_)), cm_ = frombf(tobf(c_ - ch_)), cl_ = frombf(tobf(c_ - ch_ - cm_)); \
        uint32_t on2_ = 0x3f803f80u, zz2_ = 0u; asm volatile("" : "+v"(on2_), "+v"(zz2_));     \
        u32x4 a0_, a1_; a0_[0] = on2_; a0_[1] = pack2(1.f, bh_); a0_[2] = pack2(bm_, bl_); a0_[3] = on2_; \
        a1_[0] = pack2(1.f, ch_); a1_[1] = pack2(cm_, cl_); a1_[2] = zz2_; a1_[3] = zz2_; \
        *(u32x4*)(Ks_ + tid * KROW + KD) = a0_; *(u32x4*)(Ks_ + tid * KROW + KD + 8) = a1_; \
        if (tid == 0) Ps_[64] = kmnreg; } } } while (0)

  int ntiles, glin = kt0, gword = 0; unsigned long long gcur = tm0;
  if (USEMASK) ntiles = __builtin_popcountll(tm0) + __builtin_popcountll(tm1) + __builtin_popcountll(tm2) + __builtin_popcountll(tm3);
  else ntiles = kt1 - kt0;
#define NEXT_TILE(dst_) do { if (USEMASK) { \
      while (gcur == 0ull && gword < 3) { ++gword; gcur = (gword == 1) ? tm1 : ((gword == 2) ? tm2 : tm3); } \
      dst_ = gword * 64 + (int)__builtin_ctzll(gcur); gcur &= gcur - 1ull; } else { dst_ = glin++; } } while (0)
  if (ntiles <= 0) return;
  int ktc; NEXT_TILE(ktc);

  __syncthreads();
  f32x16 Lacc[NMAP]; bf16x8 aones = {0, 0, 0, 0, 0, 0, 0, 0};
  if (LSUM) {
    uint32_t on_ = (l31 == 0) ? 0x3f803f80u : 0u; asm volatile("" : "+v"(on_));
    u32x4 ou; ou[0] = ou[1] = ou[2] = ou[3] = on_; aones = __builtin_bit_cast(bf16x8, ou);
#pragma unroll
    for (int m = 0; m < NMAP; ++m) {
      const float lt = lrun[m] + __shfl_xor(lrun[m], 32);
#pragma unroll
      for (int r = 0; r < 16; ++r) Lacc[m][r] = 0.f;
      Lacc[m][0] = h ? 0.f : lt;
      lrun[m] = 0.f;
    }
  }
  bool seeded = false;
  if (AUG) {
    seeded = (__builtin_amdgcn_ballot_w64(mrun[0] < -1e29f) == 0ull);
    if (seeded) {
#pragma unroll
      for (int m = 0; m < NMAP; ++m) {
        const float nm = -mrun[m];
        const float nh = frombf(tobf(nm)), nmd = frombf(tobf(nm - nh)), nl = frombf(tobf(nm - nh - nmd));
        uint32_t* qap = (uint32_t*)(smem + 2 * BUFBYTES + 128 * 72 * 2 + m * 4096 + tid * 16);
        if (h) qap[0] = pack2(nl, 1.f); else qap[3] = pack2(nh, nmd);
      }
    }
  }
  if (PREFETCH) { LOAD_REGS(ktc); STORE_REGS(0); } else { COPY_TILE(ktc); }
  __syncthreads();

#pragma unroll 1
  for (int it = 0; it < ntiles; ++it) {
    const int cur = PREFETCH ? (it & 1) : 0;
    const bool more = (it + 1 < ntiles);
    int ktn = ktc;
    if (more) NEXT_TILE(ktn);
    if (PREFETCH && more) LOAD_REGS(ktn);
    {
      const char* base = smem + cur * BUFBYTES;
      const bf16_t* Ks = (const bf16_t*)base; const bf16_t* Vs = (const bf16_t*)(base + KBYTES); const float* Ps = (const float*)(base + KBYTES + VBYTES);
      const float cbias = 0.f; uint32_t sgn = 0u;
      if (AUG) {
        const float kmn = Ps[64];
        const bool left = (kmn <= qmin);
        sgn = (left || h) ? 0u : 0x80008000u;
      }
#pragma unroll
      for (int mm = 0; mm < (SEQM ? NMAP : 1); ++mm) {
      const int mlo = SEQM ? mm : 0, mhi = SEQM ? mm + 1 : NMAP;
      f32x16 SS[NMAP][2];
#pragma unroll
      for (int m = mlo; m < mhi; ++m) {
#pragma unroll
        for (int mb = 0; mb < 2; ++mb)
#pragma unroll
          for (int r = 0; r < 16; ++r) SS[m][mb][r] = 0.f;
#pragma unroll
        for (int ks = 0; ks < NKS; ++ks) {
          bf16x8 a0 = *(const bf16x8*)(Ks + (l31) * KROW + (KSHARE ? 0 : m * DQK) + ks * 16 + 8 * h);
          bf16x8 a1 = *(const bf16x8*)(Ks + (32 + l31) * KROW + (KSHARE ? 0 : m * DQK) + ks * 16 + 8 * h);
          bf16x8 qv;
          if (QLDS) qv = *(const bf16x8*)((const bf16_t*)(smem + 2 * BUFBYTES) + ((tid >> 6) * 32 + l31) * 72 + m * DQK + ks * 16 + 8 * h);
          else if (KSHARE && m == 1) qv = *(const bf16x8*)((const bf16_t*)(smem + 2 * BUFBYTES) + ((tid >> 6) * 32 + l31) * (DQK + 8) + ks * 16 + 8 * h);
          else qv = qf[m][ks];
          SS[m][0] = mfma32(a0, qv, SS[m][0]);
          SS[m][1] = mfma32(a1, qv, SS[m][1]);
          if ((ks & 1) == 1) __builtin_amdgcn_sched_barrier(0);
        }
        if (AUG) {
          bf16x8 a0 = *(const bf16x8*)(Ks + (l31) * KROW + KD + 8 * h);
          bf16x8 a1 = *(const bf16x8*)(Ks + (32 + l31) * KROW + KD + 8 * h);
          u32x4 qu = *(const u32x4*)(smem + 2 * BUFBYTES + 128 * 72 * 2 + m * 4096 + tid * 16);
          qu[0] ^= sgn; qu[1] ^= sgn; qu[2] ^= sgn;
          const bf16x8 qa = __builtin_bit_cast(bf16x8, qu);
          SS[m][0] = mfma32(a0, qa, SS[m][0]);
          SS[m][1] = mfma32(a1, qa, SS[m][1]);
        }
        __builtin_amdgcn_sched_barrier(0);
      }
#pragma unroll
      for (int m = mlo; m < mhi; ++m) {
        f32x16 (&S)[2] = SS[m];
        if (POS) {
#pragma unroll
          for (int mb = 0; mb < 2; ++mb)
#pragma unroll
            for (int g = 0; g < 4; ++g) {
              float4 pk4 = *(const float4*)(Ps + mb * 32 + 8 * g + 4 * h);
#pragma unroll
              for (int i = 0; i < 4; ++i) {
                const float pkv = (i == 0) ? pk4.x : (i == 1) ? pk4.y : (i == 2) ? pk4.z : pk4.w;
                float s = S[mb][4 * g + i] - slope2 * fabsf(pq - pkv);
                if (KIND == 2) {
                  int kidx = ktc * 64 + mb * 32 + 8 * g + 4 * h + i;
                  int dd = kidx - qidx; dd = dd < 0 ? -dd : dd;
                  if (dd > 128) s = -1e30f;
                }
                S[mb][4 * g + i] = s;
              }
            }
        }
        __builtin_amdgcn_sched_barrier(0);
        float mx = S[0][0];
        if (!FAST) {
#pragma unroll
          for (int mb = 0; mb < 2; ++mb)
#pragma unroll
            for (int r = 0; r < 16; ++r) mx = fmaxf(mx, S[mb][r]);
        }
        float rs = 0.f;
        if (FAST) {
#pragma unroll
          for (int mb = 0; mb < 2; ++mb)
#pragma unroll
            for (int r = 0; r < 16; ++r) {
              float pv = fexp2(S[mb][r]); S[mb][r] = pv; if (!LSUM) rs += pv;
              if ((r & 7) == 7) __builtin_amdgcn_sched_barrier(0);
            }
        } else if (AUG) {
          mx = half_max(mx) + cbias;
          bool fix = false; float dlt = 0.f;
          if (it == 0 && !seeded) { dlt = mx; mrun[m] = mx; fix = true; }
          else if (__builtin_amdgcn_ballot_w64(mx > 0.f) != 0ull) {
            dlt = fmaxf(mx, 0.f);
            const float alpha = fexp2(-dlt);
            mrun[m] += dlt;
            lrun[m] *= alpha;
#pragma unroll
            for (int db = 0; db < NDB; ++db)
#pragma unroll
              for (int r = 0; r < 16; ++r) O[m][db][r] *= alpha;
            fix = true;
          }
          if (fix) {
#pragma unroll
            for (int mb = 0; mb < 2; ++mb)
#pragma unroll
              for (int r = 0; r < 16; ++r) S[mb][r] -= dlt;
            const float nm = -mrun[m];
            const float nh = frombf(tobf(nm)), nmd = frombf(tobf(nm - nh)), nl = frombf(tobf(nm - nh - nmd));
            uint32_t* qap = (uint32_t*)(smem + 2 * BUFBYTES + 128 * 72 * 2 + m * 4096 + tid * 16);
            if (h) qap[0] = pack2(nl, 1.f); else qap[3] = pack2(nh, nmd);
          }
#pragma unroll
          for (int mb = 0; mb < 2; ++mb)
#pragma unroll
            for (int r = 0; r < 16; ++r) { float pv = fexp2(S[mb][r]); S[mb][r] = pv; rs += pv; }
        } else {
          mx = half_max(mx) + cbias;
          if (__builtin_amdgcn_ballot_w64(mx > mrun[m]) != 0ull) {
            const float mnew = fmaxf(mrun[m], mx);
            const float alpha = fexp2(mrun[m] - mnew);
            mrun[m] = mnew;
            lrun[m] *= alpha;
#pragma unroll
            for (int db = 0; db < NDB; ++db)
#pragma unroll
              for (int r = 0; r < 16; ++r) O[m][db][r] *= alpha;
          }
          const float msub = mrun[m] - cbias;
#pragma unroll
          for (int mb = 0; mb < 2; ++mb)
#pragma unroll
            for (int r = 0; r < 16; ++r) { float pv = fexp2(S[mb][r] - msub); S[mb][r] = pv; rs += pv; }
        }
        lrun[m] += rs;
        bf16x8 pf[4];
#pragma unroll
        for (int mb = 0; mb < 2; ++mb)
#pragma unroll
          for (int s = 0; s < 2; ++s) {
            u32x4 u;
            u[0] = pack2(S[mb][8 * s + 0], S[mb][8 * s + 1]); u[1] = pack2(S[mb][8 * s + 2], S[mb][8 * s + 3]);
            u[2] = pack2(S[mb][8 * s + 4], S[mb][8 * s + 5]); u[3] = pack2(S[mb][8 * s + 6], S[mb][8 * s + 7]);
            pf[mb * 2 + s] = __builtin_bit_cast(bf16x8, u);
          }
        if (LSUM) {
#pragma unroll
          for (int kk = 0; kk < 4; ++kk) Lacc[m] = mfma32(aones, pf[kk], Lacc[m]);
        }
#pragma unroll
        for (int db = 0; db < NDB; ++db) {
#pragma unroll
          for (int kk = 0; kk < 4; ++kk) {
            bf16x8 a = *(const bf16x8*)(Vs + (db * 32 + l31) * VROW + kk * 16 + 8 * h);
            O[m][db] = mfma32(a, pf[kk], O[m][db]);
          }
          __builtin_amdgcn_sched_barrier(0);
        }
      }
      }
    }
    if (PREFETCH) {
      if (more) STORE_REGS(cur ^ 1);
      __syncthreads();
    } else {
      __syncthreads();
      if (more) { COPY_TILE(ktn); __syncthreads(); }
    }
    ktc = ktn;
  }
  if (LSUM) {
#pragma unroll
    for (int m = 0; m < NMAP; ++m) lrun[m] = h ? 0.f : Lacc[m][0];
  }
}
#undef NEXT_TILE
#undef LOAD_REGS
#undef COPY_TILE
#undef STORE_REGS

template <int DQK, int NMAP, int DV, int KIND, bool PREFETCH, bool FAST>
DI bool attn_unit(char* smem, const bf16_t* Qp, int ldq, const bf16_t* Kp, int ldk, const bf16_t* Vt, int ldv,
                  int kt0, int kt1, const int* posq, const int* posk, const float* pmm, float slope2, float sink2, int q0idx,
                  float lam, const float* headg, float outscale, bf16_t* Op, int ldo) {
  constexpr int NKS = DQK / 16, NDB = DV / 32;
  const int tid = opaque_tid(), lane = tid & 63, w = tid >> 6, l31 = lane & 31, h = lane >> 5;
  constexpr bool KSHARE = (KIND == 1);
  const int qr = KSHARE ? (64 * w + l31) : (32 * w + l31);

  bf16x8 qf[NMAP][NKS];
  {
    const bf16_t* qrow = Qp + (size_t)qr * ldq;
#pragma unroll
    for (int m = 0; m < NMAP; ++m)
#pragma unroll
      for (int ks = 0; ks < NKS; ++ks) qf[m][ks] = *(const bf16x8*)(qrow + (KSHARE ? (size_t)(32 * m) * ldq : (size_t)(m * DQK)) + ks * 16 + 8 * h);
  }
  float pq = 0.f;
  if (KIND == 0 || KIND == 2) pq = (float)posq[qr];
  const int qidx = q0idx + qr;

  f32x16 O[NMAP][NDB];
  float mrun[NMAP], lrun[NMAP];
#pragma unroll
  for (int m = 0; m < NMAP; ++m) {
#pragma unroll
    for (int db = 0; db < NDB; ++db)
#pragma unroll
      for (int r = 0; r < 16; ++r) O[m][db][r] = 0.f;
    if (KIND == 2) { mrun[m] = sink2; lrun[m] = (h == 0) ? 1.f : 0.f; }
    else { mrun[m] = -1e30f; lrun[m] = 0.f; }
  }

  bf16x8 qz = {0, 0, 0, 0, 0, 0, 0, 0};
  if (KSHARE) {
    constexpr int BUFB1 = 64 * (DQK + 8) * 2 + DV * 72 * 2 + 512;
    bf16_t* Qs = (bf16_t*)(smem + 2 * BUFB1) + (w * 32 + l31) * (DQK + 8);
#pragma unroll
    for (int ks = 0; ks < NKS; ++ks) { *(bf16x8*)(Qs + ks * 16 + 8 * h) = qf[NMAP - 1][ks]; qf[NMAP - 1][ks] = qz; }
  }
  if (KIND == 0) {
    {
      constexpr int BUFB0 = 64 * (NMAP * DQK + 16 + 8) * 2 + DV * 72 * 2 + 512;
      bf16_t* Qs = (bf16_t*)(smem + 2 * BUFB0) + (w * 32 + l31) * 72;
#pragma unroll
      for (int m = 0; m < NMAP; ++m)
#pragma unroll
        for (int ks = 0; ks < NKS; ++ks) { *(bf16x8*)(Qs + m * DQK + ks * 16 + 8 * h) = qf[m][ks]; qf[m][ks] = qz; }
    }
    float bmin = fminf((float)posq[lane], (float)posq[lane + 64]), bmax = fmaxf((float)posq[lane], (float)posq[lane + 64]);
#pragma unroll
    for (int o = 32; o >= 1; o >>= 1) { bmin = fminf(bmin, __shfl_xor(bmin, o)); bmax = fmaxf(bmax, __shfl_xor(bmax, o)); }
    unsigned long long mix[4];
#pragma unroll
    for (int j = 0; j < 4; ++j) {
      const int t = j * 64 + lane;
      const float kmn = pmm[2 * t], kmx = pmm[2 * t + 1];
      mix[j] = __builtin_amdgcn_ballot_w64((kmx > bmin) && (kmn < bmax));
    }
    const float a = -slope2 * (pq - bmin);
    const float ah = frombf(tobf(a)), am = frombf(tobf(a - ah)), al = frombf(tobf(a - ah - am));
    u32x4 up;
    if (h) { up[0] = pack2(0.f, 1.f); up[1] = pack2(1.f, 1.f); up[2] = 0u; up[3] = 0u; }
    else   { up[0] = pack2(ah, am); up[1] = pack2(al, 1.f); up[2] = pack2(1.f, 1.f); up[3] = 0u; }
    {
      constexpr int BUFB0 = 64 * (NMAP * DQK + 16 + 8) * 2 + DV * 72 * 2 + 512;
#pragma unroll
      for (int m = 0; m < NMAP; ++m) *(u32x4*)(smem + 2 * BUFB0 + 128 * 72 * 2 + m * 4096 + tid * 16) = up;
    }
    const bf16x8 qaugP = qz;
    attn_tiles<DQK, NMAP, DV, KIND, PREFETCH, false, false>(smem, tid, Kp, ldk, Vt, ldv, kt0, kt1, mix[0], mix[1], mix[2], mix[3],
                                                     posk, pmm, slope2, pq, qidx, bmin, qf, qz, O, mrun, lrun);
    attn_tiles<DQK, NMAP, DV, KIND, PREFETCH, true, FAST>(smem, tid, Kp, ldk, Vt, ldv, kt0, kt1, ~mix[0], ~mix[1], ~mix[2], ~mix[3],
                                                    posk, pmm, slope2, pq, qidx, bmin, qf, qaugP, O, mrun, lrun);
  } else {
    attn_tiles<DQK, NMAP, DV, KIND, PREFETCH, false, FAST>(smem, tid, Kp, ldk, Vt, ldv, kt0, kt1, 0ull, 0ull, 0ull, 0ull,
                                                     posk, pmm, slope2, pq, qidx, 0.f, qf, qz, O, mrun, lrun);
  }

  if (FAST) {
    bool bad = false;
#pragma unroll
    for (int m = 0; m < NMAP; ++m) { const float lt = lrun[m] + __shfl_xor(lrun[m], 32); bad = bad || !(lt > 9.0e-13f && lt < 1.0e18f); }
    __shared__ unsigned sflag[4];
    const unsigned long long bm = __builtin_amdgcn_ballot_w64(bad);
    if (lane == 0) sflag[w] = (bm != 0ull) ? 1u : 0u;
    __syncthreads();
    const unsigned anybad = sflag[0] | sflag[1] | sflag[2] | sflag[3];
    __syncthreads();
    if (anybad) return true;
  }
  float inv[NMAP];
#pragma unroll
  for (int m = 0; m < NMAP; ++m) { float lt = lrun[m] + __shfl_xor(lrun[m], 32); inv[m] = 1.f / lt; }
  bf16_t* orow = Op + (size_t)qr * ldo;
  if (KIND == 0) {
    float ss = 0.f;
#pragma unroll
    for (int db = 0; db < NDB; ++db)
#pragma unroll
      for (int r = 0; r < 16; ++r) {
        float o = O[0][db][r] * inv[0] - lam * (O[NMAP - 1][db][r] * inv[NMAP - 1]);
        O[0][db][r] = o; ss += o * o;
      }
    ss += __shfl_xor(ss, 32);
    const float rs = rsqrtf(ss * (1.f / 64.f) + EPSN) * outscale;
#pragma unroll
    for (int db = 0; db < NDB; ++db)
#pragma unroll
      for (int g = 0; g < 4; ++g) {
        int dv = db * 32 + 8 * g + 4 * h;
        float4 gg = *(const float4*)(headg + dv);
        uint2 u; u.x = pack2(O[0][db][4 * g] * rs * gg.x, O[0][db][4 * g + 1] * rs * gg.y);
        u.y = pack2(O[0][db][4 * g + 2] * rs * gg.z, O[0][db][4 * g + 3] * rs * gg.w);
        *(uint2*)(orow + dv) = u;
      }
  } else {
#pragma unroll
    for (int m = 0; m < (KSHARE ? NMAP : 1); ++m)
#pragma unroll
      for (int db = 0; db < NDB; ++db)
#pragma unroll
        for (int g = 0; g < 4; ++g) {
          int dv = db * 32 + 8 * g + 4 * h;
          uint2 u; u.x = pack2(O[m][db][4 * g] * inv[m], O[m][db][4 * g + 1] * inv[m]);
          u.y = pack2(O[m][db][4 * g + 2] * inv[m], O[m][db][4 * g + 3] * inv[m]);
          *(uint2*)(orow + (size_t)(32 * m) * ldo + dv) = u;
        }
  }
  return false;
}
DI void phase_rows_init_or_res3(const Params& p, int l, bool init, char* smem) {
  const int tid_ = opaque_tid(); const int lane = tid_ & 63, w = tid_ >> 6;
  bf16_t* H = (bf16_t*)(p.ws + OFF_H);
  const bf16_t* Y = (const bf16_t*)(p.ws + OFF_Y);
  const int nl = init ? 0 : l + 1;
  for (int row = blockIdx.x * 4 + w; row < NTOK; row += gridDim.x * 4) {
    size_t ro = (size_t)row * 1024;
    if (init) row_op<false, true>(p.x_in + ro, nullptr, nullptr, nullptr, p.g_mix_pre, H + ro, lane);
    else if (l < DEPTH - 1) row_op<true, true>(p.xres + ro, Y + ro, p.g_ffn_post + l * 1024, p.xres + ro, p.g_mix_pre + (l + 1) * 1024, H + ro, lane);
    else row_op<true, false>(p.xres + ro, Y + ro, p.g_ffn_post + l * 1024, p.xres + ro, nullptr, nullptr, lane);
  }
  if (init) {
    float* PMM = (float*)(p.ws + OFF_SM + 3 * MiB);
    for (int t = blockIdx.x * 4 + w; t < NTOK / 64; t += gridDim.x * 4) {
      float v = (float)p.pos[t * 64 + lane]; float mn = v, mx = v;
#pragma unroll
      for (int o = 32; o >= 1; o >>= 1) { mn = fminf(mn, __shfl_xor(mn, o)); mx = fmaxf(mx, __shfl_xor(mx, o)); }
      if (lane == 0) { PMM[2 * t] = mn; PMM[2 * t + 1] = mx; }
    }
  }
  if (nl < DEPTH) {
    bf16_t* MEMN = (bf16_t*)(p.ws + OFF_SM);
    for (int row = blockIdx.x * 4 + w; row < 512; row += gridDim.x * 4) {
      size_t ro = (size_t)row * 1024;
      row_op<false, true>(p.mem + ro, nullptr, nullptr, nullptr, p.g_x_mem + nl * 1024, MEMN + ro, lane);
    }
    convert_weights(p, nl, smem);
  }
}

DI void phase_rows_res(const Params& p, const float* xsrc, const float* gpost, const float* gnext) {
  const int tid_ = opaque_tid(); const int lane = tid_ & 63, w = tid_ >> 6;
  bf16_t* H = (bf16_t*)(p.ws + OFF_H);
  const bf16_t* Y = (const bf16_t*)(p.ws + OFF_Y);
  for (int row = blockIdx.x * 4 + w; row < NTOK; row += gridDim.x * 4) {
    size_t ro = (size_t)row * 1024;
    row_op<true, true>(xsrc + ro, Y + ro, gpost, p.xres + ro, gnext, H + ro, lane);
  }
}

DI void phase_rows_mla(const Params& p, int l) {
  const int tid_ = opaque_tid(); const int lane = tid_ & 63, w = tid_ >> 6;
  const bf16_t* PROJ = (const bf16_t*)(p.ws + OFF_BIG);
  bf16_t* MLAN = (bf16_t*)(p.ws + OFF_Y);
  bf16_t* KB = (bf16_t*)(p.ws + OFF_Y + 48 * MiB);
  const float* gq = p.mla_q_norm_g + l * 256;
  const float* gkv = p.mla_kv_norm_g + l * 128;
  for (int row = blockIdx.x * 4 + w; row < NTOK; row += gridDim.x * 4) {
    const bf16_t* pr = PROJ + (size_t)row * 2048;
    uint2 cq = *(const uint2*)(pr + 768 + lane * 4);
    uint32_t ckv = *(const uint32_t*)(pr + 1024 + lane * 2);
    float q0 = frombf(cq.x & 0xffffu), q1 = frombf(cq.x >> 16), q2 = frombf(cq.y & 0xffffu), q3 = frombf(cq.y >> 16);
    float k0 = frombf(ckv & 0xffffu), k1 = frombf(ckv >> 16);
    float ssq = wave_sum(q0 * q0 + q1 * q1 + q2 * q2 + q3 * q3);
    float ssk = wave_sum(k0 * k0 + k1 * k1);
    float rq = rsqrtf(ssq * (1.f / 256.f) + EPSN), rk = rsqrtf(ssk * (1.f / 128.f) + EPSN);
    float4 g4 = *(const float4*)(gq + lane * 4);
    float2 g2 = *(const float2*)(gkv + lane * 2);
    uint2 u; u.x = pack2(q0 * rq * g4.x, q1 * rq * g4.y); u.y = pack2(q2 * rq * g4.z, q3 * rq * g4.w);
    *(uint2*)(MLAN + (size_t)row * 384 + lane * 4) = u;
    *(uint32_t*)(MLAN + (size_t)row * 384 + 256 + lane * 2) = pack2(k0 * rk * g2.x, k1 * rk * g2.y);
    if (lane < 16) {
      float x1 = frombf(pr[1152 + lane]), x2 = frombf(pr[1152 + 16 + lane]);
      float ang = (float)p.pos[row] * rope_inv(lane);
      float s, c; sincos_red(ang, s, c);
      bf16_t o1 = tobf(x1 * c - x2 * s), o2 = tobf(x1 * s + x2 * c);
      bf16_t* kb = KB + (size_t)row * 384;
#pragma unroll
      for (int hd = 0; hd < 4; ++hd) { kb[hd * 96 + 64 + lane] = o1; kb[hd * 96 + 80 + lane] = o2; }
    }
  }
}

DI void phase_attn(const Params& p, int l, char* smem) {
  const int xcd = blockIdx.x & 7, slot = blockIdx.x >> 3, nslots = gridDim.x >> 3;
  const bf16_t* PROJ = (const bf16_t*)(p.ws + OFF_BIG);
  bf16_t* MIX = (bf16_t*)(p.ws + OFF_BIG + 128 * MiB);
  const bf16_t* QB = (const bf16_t*)(p.ws + OFF_Y + 24 * MiB);
  const bf16_t* KB = (const bf16_t*)(p.ws + OFF_Y + 48 * MiB);
  const bf16_t* VtA = (const bf16_t*)(p.ws + OFF_Y + 72 * MiB);
  const bf16_t* VtB = (const bf16_t*)(p.ws + OFF_Y + 88 * MiB);
  const bf16_t* VtC = (const bf16_t*)(p.ws + OFF_Y + 104 * MiB);
  const float* PMM = (const float*)(p.ws + OFF_SM + 3 * MiB);
  const float* lp = p.diff_lambda + l * 128;
  float d0 = 0.f, d1 = 0.f;
  for (int i = 0; i < 32; ++i) { d0 += lp[i] * lp[32 + i]; d1 += lp[64 + i] * lp[96 + i]; }
  const float lam_init = __uint_as_float(__builtin_amdgcn_readfirstlane(__float_as_uint(0.8f - 0.6f * expf(-0.3f * (float)l))));
  const float lam = __uint_as_float(__builtin_amdgcn_readfirstlane(__float_as_uint(expf(d0) - expf(d1) + lam_init)));
  const int b = xcd >> 2, head = xcd & 3;
  if (ATT_SEL & 1) {
    const float slope2 = exp2f(-8.f * (float)(9 + head) / 12.f) * LOG2E;
    unsigned failA = 0u; int ia = 0;
    for (int qb = slot; qb < 128; qb += nslots, ++ia) {
      const size_t t0 = (size_t)b * SEQ + qb * 128;
      const bool rd = attn_unit<32, 2, 64, 0, true, true>(smem, PROJ + t0 * 2048 + head * 64, 2048, PROJ + (size_t)b * SEQ * 2048 + 256 + head * 64, 2048,
                                    VtA + (size_t)(b * 4 + head) * 64 * SEQ, SEQ, 0, SEQ / 64, p.pos + t0, p.pos + (size_t)b * SEQ, PMM + b * 512, slope2, 0.f, qb * 128,
                                    lam, p.diff_head_g + l * 64, 1.f - lam_init, MIX + t0 * 1024 + head * 64, 1024);
      if (rd) failA |= 1u << ia;
    }
    ia = 0;
    for (int qb = slot; qb < 128; qb += nslots, ++ia) {
      if (!((failA >> ia) & 1u)) continue;
      const size_t t0 = (size_t)b * SEQ + qb * 128;
      (void)attn_unit<32, 2, 64, 0, true, false>(smem, PROJ + t0 * 2048 + head * 64, 2048, PROJ + (size_t)b * SEQ * 2048 + 256 + head * 64, 2048,
                                    VtA + (size_t)(b * 4 + head) * 64 * SEQ, SEQ, 0, SEQ / 64, p.pos + t0, p.pos + (size_t)b * SEQ, PMM + b * 512, slope2, 0.f, qb * 128,
                                    lam, p.diff_head_g + l * 64, 1.f - lam_init, MIX + t0 * 1024 + head * 64, 1024);
    }
  }
  if (ATT_SEL & 2) {
    unsigned failB = 0u; int ib = 0;
    for (int qb = slot; qb < 64; qb += nslots, ++ib) {
      const size_t t0 = (size_t)b * SEQ + qb * 256;
      const bool rd = attn_unit<96, 2, 64, 1, true, true>(smem, QB + t0 * 384 + head * 96, 384, KB + (size_t)b * SEQ * 384 + head * 96, 384,
                                    VtB + (size_t)(b * 4 + head) * 64 * SEQ, SEQ, 0, SEQ / 64, nullptr, nullptr, nullptr, 0.f, 0.f, qb * 256,
                                    0.f, nullptr, 1.f, MIX + t0 * 1024 + 256 + head * 64, 1024);
      if (rd) failB |= 1u << ib;
    }
    ib = 0;
    for (int qb = slot; qb < 64; qb += nslots, ++ib) {
      if (!((failB >> ib) & 1u)) continue;
      const size_t t0 = (size_t)b * SEQ + qb * 256;
      (void)attn_unit<96, 2, 64, 1, true, false>(smem, QB + t0 * 384 + head * 96, 384, KB + (size_t)b * SEQ * 384 + head * 96, 384,
                                    VtB + (size_t)(b * 4 + head) * 64 * SEQ, SEQ, 0, SEQ / 64, nullptr, nullptr, nullptr, 0.f, 0.f, qb * 256,
                                    0.f, nullptr, 1.f, MIX + t0 * 1024 + 256 + head * 64, 1024);
    }
  }
  if (ATT_SEL & 4) for (int j = slot; j < 256; j += nslots) {
    const int hq = (xcd & 3) * 2 + (j >> 7), qb = j & 127, kvh = hq >> 2;
    const size_t t0 = (size_t)b * SEQ + qb * 128;
    const float slope2 = exp2f(-8.f * (float)(hq + 1) / 12.f) * LOG2E;
    const float sink2 = p.swa_sinks[l * 8 + hq] * LOG2E;
    int kt0 = 2 * qb - 2, kt1 = 2 * qb + 4;
    if (kt0 < 0) kt0 = 0;
    if (kt1 > SEQ / 64) kt1 = SEQ / 64;
    (void)attn_unit<64, 1, 64, 2, true, false>(smem, PROJ + t0 * 2048 + 1184 + hq * 64, 2048, PROJ + (size_t)b * SEQ * 2048 + 1696 + kvh * 64, 2048,
                                  VtC + (size_t)(b * 2 + kvh) * 64 * SEQ, SEQ, kt0, kt1, p.pos + t0, p.pos + (size_t)b * SEQ, nullptr, slope2, sink2, qb * 128,
                                  0.f, nullptr, 1.f, MIX + t0 * 1024 + 512 + hq * 64, 1024);
  }
}

DI void phase_xattn(const Params& p, char* smem) {
  const int xcd = blockIdx.x & 7, slot = blockIdx.x >> 3, nslots = gridDim.x >> 3;
  const bf16_t* QX = (const bf16_t*)(p.ws + OFF_BIG);
  bf16_t* OX = (bf16_t*)(p.ws + OFF_BIG + 64 * MiB);
  const bf16_t* KX = (const bf16_t*)(p.ws + OFF_SM + 1 * MiB);
  const bf16_t* VtX = (const bf16_t*)(p.ws + OFF_SM + 2 * MiB);
  const int b = xcd >> 2, head = xcd & 3;
  unsigned failX = 0u; int ix = 0;
  for (int j = slot; j < 256; j += nslots, ++ix) {
    const int dvh = j >> 7, qb = j & 127;
    const size_t t0 = (size_t)b * SEQ + qb * 128;
    const bool rd = attn_unit<256, 1, 128, 3, false, true>(smem, QX + t0 * 1024 + head * 256, 1024, KX + (size_t)b * 256 * 1024 + head * 256, 1024,
                                     VtX + ((size_t)(b * 4 + head) * 256 + dvh * 128) * 256, 256, 0, 4, nullptr, nullptr, nullptr, 0.f, 0.f, 0,
                                     0.f, nullptr, 1.f, OX + t0 * 1024 + head * 256 + dvh * 128, 1024);
    if (rd) failX |= 1u << ix;
  }
  ix = 0;
  for (int j = slot; j < 256; j += nslots, ++ix) {
    if (!((failX >> ix) & 1u)) continue;
    const int dvh = j >> 7, qb = j & 127;
    const size_t t0 = (size_t)b * SEQ + qb * 128;
    (void)attn_unit<256, 1, 128, 3, false, false>(smem, QX + t0 * 1024 + head * 256, 1024, KX + (size_t)b * 256 * 1024 + head * 256, 1024,
                                     VtX + ((size_t)(b * 4 + head) * 256 + dvh * 128) * 256, 256, 0, 4, nullptr, nullptr, nullptr, 0.f, 0.f, 0,
                                     0.f, nullptr, 1.f, OX + t0 * 1024 + head * 256 + dvh * 128, 1024);
  }
}

DI void run_phase(const Params& p, int ph, char* smem) {
  bf16_t* W = (bf16_t*)(p.ws + OFF_W);
  bf16_t* H = (bf16_t*)(p.ws + OFF_H);
  bf16_t* BIG = (bf16_t*)(p.ws + OFF_BIG);
  if (ph == 0) { phase_rows_init_or_res3(p, 0, true, smem); return; }
  const int l = (ph - 1) / 13, s = (ph - 1) % 13;
  switch (s) {
    case 0:
      gemm_phase_g<EPI_PROJ>(p, smem, H, 1024, W + WO_IN, 1024, 256, 8);
      gemm_phase<EPI_XKV>(p, smem, (const bf16_t*)(p.ws + OFF_SM), 1024, W + WO_XKV, 1024, 4, 16, 0);
      break;
    case 1: phase_rows_mla(p, l); break;
    case 2:
      gemm_phase<EPI_QUP>(p, smem, (const bf16_t*)(p.ws + OFF_Y), 384, W + WO_QUP, 256, 256, 3, 1);
      gemm_phase<EPI_KVUP>(p, smem, (const bf16_t*)(p.ws + OFF_Y) + 256, 384, W + WO_KVUP, 128, 256, 4, 1);
      break;
    case 3: phase_attn(p, l, smem); break;
    case 4: gemm_phase_g<EPI_F32>(p, smem, BIG + (size_t)64 * MiB, 1024, W + WO_OUT, 1024, 256, 4); break;
    case 5: phase_rows_res(p, l == 0 ? p.x_in : p.xres, p.g_mix_post + l * 1024, p.g_x_pre + l * 1024); break;
    case 6: gemm_phase_g<EPI_XQ>(p, smem, H, 1024, W + WO_XQ, 1024, 256, 4); break;
    case 7: phase_xattn(p, smem); break;
    case 8: gemm_phase_g<EPI_F32>(p, smem, BIG + (size_t)32 * MiB, 1024, W + WO_XO, 1024, 256, 4); break;
    case 9: phase_rows_res(p, p.xres, p.g_x_post + l * 1024, p.g_ffn_pre + l * 1024); break;
    case 10: gemm_phase_g<EPI_SWIGLU>(p, smem, H, 1024, W + WO_FI, 1024, 256, 22); break;
    case 11: gemm_phase_g<EPI_F32>(p, smem, BIG, DFF, W + WO_FO, DFF, 256, 4); break;
    case 12: phase_rows_init_or_res3(p, l, false, smem); break;
  }
}

constexpr int NPHASES = 1 + 13 * DEPTH;

__global__ void __launch_bounds__(NTHREADS, 2) fwd_megakernel(Params p) {
  __shared__ __attribute__((aligned(16))) char smem[SMEM_BYTES];
  __shared__ uint4 xb_words;
  cg::grid_group grid = cg::this_grid();
  if (threadIdx.x == 0) xb_words = make_uint4(0u, 0u, 0u, 0u);
  __syncthreads();
  XcdBarrier xb = xcd_barrier_post((unsigned*)(p.ws + OFF_BAR), (volatile LAS unsigned*)&xb_words);
  for (int ph = p.phase_begin; ph < p.phase_end; ++ph) {
    {
#if defined(__HIP_DEVICE_COMPILE__)
      typedef const Params __attribute__((address_space(4)))* KargPtr;
      KargPtr pp = (KargPtr)__builtin_amdgcn_kernarg_segment_ptr();
      asm volatile("" : "+s"(pp));
      const Params q = *pp;
#else
      const Params q = p;
#endif
      run_phase(q, ph, smem);
#if PROBE_DUP
      if (ph > 0 && ((PROBE_DUP >> ((ph - 1) % 13)) & 1)) { __syncthreads(); run_phase(q, ph, smem); }
#endif
    }
    if (ph + 1 < p.phase_end) {
      if (p.phase_begin < 0) grid.sync();
      xcd_barrier(xb);
    }
  }
}

extern "C" void kernel_launch(void* const* d_in, const int* in_sizes, int n_in, void* d_out, int out_size, void* d_ws, size_t ws_size,
                              hipStream_t stream) {
  static int grid_blocks = 0;
  if (!grid_blocks) {
    int dev = 0, cus = 0, per_cu = 0;
    hipGetDevice(&dev);
    hipDeviceGetAttribute(&cus, hipDeviceAttributeMultiprocessorCount, dev);
    hipOccupancyMaxActiveBlocksPerMultiprocessor(&per_cu, fwd_megakernel, NTHREADS, 0);
    if (per_cu > 2) per_cu = 2;
    if (per_cu < 1) per_cu = 1;
    grid_blocks = cus * per_cu;
    grid_blocks &= ~7;
  }
  Params p{};
  p.x_in = (const float*)d_in[0]; p.mem = (const float*)d_in[1]; p.pos = (const int*)d_in[2];
  p.g_mix_pre = (const float*)d_in[3]; p.g_mix_post = (const float*)d_in[4]; p.w_in = (const float*)d_in[5];
  p.diff_lambda = (const float*)d_in[6]; p.diff_head_g = (const float*)d_in[7]; p.mla_q_norm_g = (const float*)d_in[8];
  p.mla_w_q_up = (const float*)d_in[9]; p.mla_kv_norm_g = (const float*)d_in[10]; p.mla_w_kv_up = (const float*)d_in[11];
  p.swa_sinks = (const float*)d_in[12]; p.w_out = (const float*)d_in[13]; p.g_x_pre = (const float*)d_in[14];
  p.g_x_mem = (const float*)d_in[15]; p.g_x_post = (const float*)d_in[16]; p.w_xq = (const float*)d_in[17];
  p.w_xkv = (const float*)d_in[18]; p.w_xo = (const float*)d_in[19]; p.g_ffn_pre = (const float*)d_in[20];
  p.g_ffn_post = (const float*)d_in[21]; p.w_ffn_in = (const float*)d_in[22]; p.w_ffn_out = (const float*)d_in[23];
  p.xres = (float*)d_out; p.ws = (char*)d_ws;
#if SINGLE_LAUNCH
  hipMemsetAsync((char*)d_ws + OFF_BAR, 0, XCD_BAR_WORDS * sizeof(unsigned), stream);
  p.phase_begin = 0; p.phase_end = NPHASES;
  void* args[] = {&p};
  hipError_t e = hipLaunchCooperativeKernel((void*)fwd_megakernel, dim3(grid_blocks), dim3(NTHREADS), args, 0, stream);
  if (e != hipSuccess) fprintf(stderr, "cooperative launch failed: %s (grid %d)\n", hipGetErrorString(e), grid_blocks);
#else
  for (int ph = 0; ph < NPHASES; ++ph) {
    p.phase_begin = ph; p.phase_end = ph + 1;
    fwd_megakernel<<<dim3(grid_blocks), dim3(NTHREADS), 0, stream>>>(p);
  }
#endif
}
```

```cpp
#include <hip/hip_runtime.h>
#include <hip/hip_cooperative_groups.h>
#include <stdint.h>
#include <stdio.h>
namespace cg = cooperative_groups;

#ifndef SINGLE_LAUNCH
#define SINGLE_LAUNCH 1
#endif

#ifndef PROBE_DUP
#define PROBE_DUP 0
#endif
#ifndef ATT_SEL
#define ATT_SEL 7
#endif
#define DI __device__ __forceinline__
typedef unsigned short bf16_t;
typedef __attribute__((ext_vector_type(8))) short bf16x8;
typedef __attribute__((ext_vector_type(16))) float f32x16;
typedef __bf16 bf16x2_t __attribute__((ext_vector_type(2)));
typedef float f32x2_t __attribute__((ext_vector_type(2)));
typedef uint32_t u32x4 __attribute__((ext_vector_type(4)));
typedef uint32_t u32x2 __attribute__((ext_vector_type(2)));
typedef float f32x4 __attribute__((ext_vector_type(4)));

constexpr int SEQ = 16384, NTOK = 32768, DM = 1024, DFF = 2816, DIN = 1952, DEPTH = 4;
constexpr float LOG2E = 1.4426950408889634f;
constexpr float EPSN = 1e-6f;
constexpr int NTHREADS = 256;
constexpr int SMEM_BYTES = 73728;

constexpr size_t MiB = 1ull << 20;
constexpr size_t OFF_W = 0, OFF_H = 33 * MiB, OFF_Y = 97 * MiB, OFF_BIG = 225 * MiB, OFF_SM = 417 * MiB, OFF_BAR = 421 * MiB;
constexpr size_t WO_IN = 0;
constexpr size_t WO_QUP = WO_IN + 2048 * 1024;
constexpr size_t WO_KVUP = WO_QUP + 384 * 256;
constexpr size_t WO_OUT = WO_KVUP + 512 * 128;
constexpr size_t WO_XQ = WO_OUT + 1024 * 1024;
constexpr size_t WO_XKV = WO_XQ + 1024 * 1024;
constexpr size_t WO_XO = WO_XKV + 2048 * 1024;
constexpr size_t WO_FI = WO_XO + 1024 * 1024;
constexpr size_t WO_FO = WO_FI + 5632 * 1024;

struct Params {
  const float* x_in; const float* mem; const int* pos;
  const float* g_mix_pre; const float* g_mix_post; const float* w_in; const float* diff_lambda; const float* diff_head_g;
  const float* mla_q_norm_g; const float* mla_w_q_up; const float* mla_kv_norm_g; const float* mla_w_kv_up;
  const float* swa_sinks; const float* w_out; const float* g_x_pre; const float* g_x_mem; const float* g_x_post;
  const float* w_xq; const float* w_xkv; const float* w_xo; const float* g_ffn_pre; const float* g_ffn_post;
  const float* w_ffn_in; const float* w_ffn_out;
  float* xres;
  char* ws;
  int phase_begin, phase_end, pad0, pad1;
};

DI uint32_t pack2(float a, float b) { f32x2_t v = {a, b}; bf16x2_t r = __builtin_convertvector(v, bf16x2_t); return __builtin_bit_cast(uint32_t, r); }
DI bf16_t tobf(float a) { return (bf16_t)(pack2(a, 0.f) & 0xffffu); }
DI float frombf(uint32_t v) { return __uint_as_float(v << 16); }
DI f32x16 mfma32(bf16x8 a, bf16x8 b, f32x16 c) { return __builtin_amdgcn_mfma_f32_32x32x16_bf16(a, b, c, 0, 0, 0); }
DI int opaque_tid() { int t = threadIdx.x; asm volatile("" : "+v"(t)); return t; }
DI float fexp2(float x) { return __builtin_amdgcn_exp2f(x); }
DI float wave_sum(float v) {
#pragma unroll
  for (int o = 32; o >= 1; o >>= 1) v += __shfl_xor(v, o);
  return v;
}
DI float half_max(float v) {
  auto r = __builtin_amdgcn_permlane32_swap(__float_as_uint(v), __float_as_uint(v), false, false);
  return fmaxf(__uint_as_float(r[0]), __uint_as_float(r[1]));
}
DI float rope_inv(int i) { return exp2f(-(float)i * 0.8304820237218406f); }
DI void sincos_red(float ang, float& s, float& c) {
  double a = (double)ang;
  double k = rint(a * 0.15915494309189535);
  float r = (float)(a - k * 6.283185307179586);
  s = sinf(r); c = cosf(r);
}
DI void store_vt(bf16_t* rowbase, int tok32, int g, int h, float v0, float v1, float v2, float v3) {
  int pos = tok32 + 16 * (g >> 1) + 8 * h + 4 * (g & 1);
  uint2 u; u.x = pack2(v0, v1); u.y = pack2(v2, v3);
  *(uint2*)(rowbase + pos) = u;
}


#define XB_TMO      128
#define XB_XCNT(j)  (256  + 64 * (j))
#define XB_XSUB(j)  (1280 + 64 * (j))
#define XB_XGEN(j)  (2304 + 64 * (j))
#define XB_TOP      3328
#define XB_TOPGEN   3392
#define XCD_BAR_WORDS 3456
#define XB_SPIN_CAP (1u << 22)
#define LAS __attribute__((address_space(3)))
DI unsigned xb_ld(unsigned* p)              { return __hip_atomic_load(p, __ATOMIC_RELAXED, __HIP_MEMORY_SCOPE_AGENT); }
DI unsigned xb_add(unsigned* p, unsigned v) { return __hip_atomic_fetch_add(p, v, __ATOMIC_RELAXED, __HIP_MEMORY_SCOPE_AGENT); }
DI unsigned xb_xcc_id() { return (unsigned)__builtin_amdgcn_s_getreg((3 << 11) | 20) & 0xFu; }
#define XB_SPIN(cond, bar) do { unsigned _sp = 0; while (cond) { __builtin_amdgcn_s_sleep(1); \
    if ((++_sp & 255u) == 0u) { if (xb_ld(&(bar)[XB_TMO])) break; if (_sp > XB_SPIN_CAP) { atomicAdd(&(bar)[XB_TMO], 1u); break; } } } } while (0)
struct XcdBarrier { unsigned* bar; unsigned x; volatile LAS unsigned* st; };
DI XcdBarrier xcd_barrier_post(unsigned* bar, volatile LAS unsigned* st) {
  XcdBarrier b; b.bar = bar; b.x = xb_xcc_id(); b.st = st;
  if (threadIdx.x == 0) (void)xb_add(&bar[XB_XCNT(b.x)], 1u);
  return b;
}
DI void xcd_barrier_complete(unsigned* bar, unsigned x, unsigned& nloc, unsigned& nx) {
  const unsigned G = gridDim.x * gridDim.y * gridDim.z;
  unsigned sum, cnt, mine, sp = 0u;
  for (;;) {
    sum = 0u; cnt = 0u; mine = 0u;
#pragma unroll
    for (unsigned j = 0; j < 16; ++j) { const unsigned c = xb_ld(&bar[XB_XCNT(j)]); sum += c; cnt += (c > 0u) ? 1u : 0u; mine = (j == x) ? c : mine; }
    if (sum == G) break;
    __builtin_amdgcn_s_sleep(1);
    if ((++sp & 255u) == 0u) { if (xb_ld(&bar[XB_TMO])) break; if (sp > XB_SPIN_CAP) { atomicAdd(&bar[XB_TMO], 1u); break; } }
  }
  nloc = mine > 0u ? mine : 1u; nx = cnt > 0u ? cnt : 1u;
}
DI void xcd_barrier(const XcdBarrier& b) {
  asm volatile("s_waitcnt vmcnt(0)" ::: "memory");
  __syncthreads();
  if (threadIdx.x == 0) {
    unsigned* bar = b.bar;
    __builtin_amdgcn_s_waitcnt(0);
    unsigned nloc = b.st[0], nx = b.st[1];
    if (nloc == 0u) { xcd_barrier_complete(bar, b.x, nloc, nx); b.st[0] = nloc; b.st[1] = nx; }
    const unsigned old = xb_add(&bar[XB_XSUB(b.x)], 1u);
    const unsigned gen = old / nloc;
    if (old + 1u == (gen + 1u) * nloc) {
      __builtin_amdgcn_fence(__ATOMIC_RELEASE, "agent");
      asm volatile("s_waitcnt vmcnt(0)" ::: "memory");
      const unsigned og = xb_add(&bar[XB_TOP], 1u);
      const unsigned tg = og / nx;
      if (og + 1u == (tg + 1u) * nx) xb_add(&bar[XB_TOPGEN], 1u);
      else XB_SPIN(xb_ld(&bar[XB_TOPGEN]) == tg, bar);
      __builtin_amdgcn_fence(__ATOMIC_ACQUIRE, "agent");
      xb_add(&bar[XB_XGEN(b.x)], 1u);
      asm volatile("s_waitcnt vmcnt(0)" ::: "memory");
    } else {
      XB_SPIN(xb_ld(&bar[XB_XGEN(b.x)]) == gen, bar);
      __builtin_amdgcn_fence(__ATOMIC_ACQUIRE, "agent");
      asm volatile("s_waitcnt vmcnt(0)" ::: "memory");
    }
  }
  __syncthreads();
}

DI void convert_weights(const Params& p, int l, char* smem) {
  const int tid = opaque_tid();
  bf16_t* W = (bf16_t*)(p.ws + OFF_W);
  float* tile = (float*)smem;
  for (int t = blockIdx.x; t < 7840; t += gridDim.x) {
    const float* src; int K, N, lt, mode = 0; bf16_t* dst;
    if (t < 976)       { src = p.w_in + (size_t)l * 1024 * 1952;      K = 1024; N = 1952; dst = W + WO_IN;   lt = t; }
    else if (t < 1024) { src = p.mla_w_q_up + (size_t)l * 256 * 384;  K = 256;  N = 384;  dst = W + WO_QUP;  lt = t - 976; }
    else if (t < 1056) { src = p.mla_w_kv_up + (size_t)l * 128 * 512; K = 128;  N = 512;  dst = W + WO_KVUP; lt = t - 1024; }
    else if (t < 1568) { src = p.w_out + (size_t)l * 1024 * 1024;     K = 1024; N = 1024; dst = W + WO_OUT;  lt = t - 1056; }
    else if (t < 2080) { src = p.w_xq + (size_t)l * 1024 * 1024;      K = 1024; N = 1024; dst = W + WO_XQ;   lt = t - 1568; }
    else if (t < 3104) { src = p.w_xkv + (size_t)l * 1024 * 2048;     K = 1024; N = 2048; dst = W + WO_XKV;  lt = t - 2080; }
    else if (t < 3616) { src = p.w_xo + (size_t)l * 1024 * 1024;      K = 1024; N = 1024; dst = W + WO_XO;   lt = t - 3104; }
    else if (t < 6432) { src = p.w_ffn_in + (size_t)l * 1024 * 5632;  K = 1024; N = 5632; dst = W + WO_FI;   lt = t - 3616; mode = 1; }
    else               { src = p.w_ffn_out + (size_t)l * 2816 * 1024; K = 2816; N = 1024; dst = W + WO_FO;   lt = t - 6432; }
    const int nNt = N >> 5;
    const int k0 = (lt / nNt) * 64, n0 = (lt % nNt) * 32;
#pragma unroll
    for (int it = 0; it < 2; ++it) {
      const int c = tid + 256 * it, i = c >> 3, j4 = (c & 7) * 4;
      const float4 v = *(const float4*)(src + (size_t)(k0 + i) * N + n0 + j4);
      tile[i * 33 + j4] = v.x; tile[i * 33 + j4 + 1] = v.y; tile[i * 33 + j4 + 2] = v.z; tile[i * 33 + j4 + 3] = v.w;
    }
    __syncthreads();
    {
      const int jn = tid & 31, kg = (tid >> 5) * 8;
      u32x4 o;
      o[0] = pack2(tile[(kg + 0) * 33 + jn], tile[(kg + 1) * 33 + jn]);
      o[1] = pack2(tile[(kg + 2) * 33 + jn], tile[(kg + 3) * 33 + jn]);
      o[2] = pack2(tile[(kg + 4) * 33 + jn], tile[(kg + 5) * 33 + jn]);
      o[3] = pack2(tile[(kg + 6) * 33 + jn], tile[(kg + 7) * 33 + jn]);
      int n = n0 + jn, drow = n;
      if (mode == 1) drow = (n < DFF) ? ((n >> 5) * 64 + (n & 31)) : ((((n - DFF) >> 5) * 64) + 32 + ((n - DFF) & 31));
      *(u32x4*)(dst + (size_t)drow * K + k0 + kg) = o;
    }
    __syncthreads();
  }
  uint32_t* padp = (uint32_t*)(W + WO_IN + (size_t)1952 * 1024);
  for (int i = blockIdx.x * NTHREADS + tid; i < 49152; i += gridDim.x * NTHREADS) padp[i] = 0u;
}

template <bool RES, bool NORM2>
DI void row_op(const float* xsrc, const bf16_t* Yrow, const float* gpost, float* xdst, const float* gnext, bf16_t* Hout, int lane) {
  float4 xv[4];
#pragma unroll
  for (int j = 0; j < 4; ++j) { const f32x4 t_ = __builtin_nontemporal_load((const f32x4*)(xsrc + j * 256 + lane * 4)); xv[j].x = t_[0]; xv[j].y = t_[1]; xv[j].z = t_[2]; xv[j].w = t_[3]; }
  if (RES) {
    float4 yv[4]; float ss = 0.f;
#pragma unroll
    for (int j = 0; j < 4; ++j) {
      const u32x2 yt_ = __builtin_nontemporal_load((const u32x2*)(Yrow + j * 256 + lane * 4)); uint2 yu; yu.x = yt_[0]; yu.y = yt_[1];
      yv[j].x = frombf(yu.x & 0xffffu); yv[j].y = frombf(yu.x >> 16); yv[j].z = frombf(yu.y & 0xffffu); yv[j].w = frombf(yu.y >> 16);
      ss += yv[j].x * yv[j].x + yv[j].y * yv[j].y + yv[j].z * yv[j].z + yv[j].w * yv[j].w;
    }
    ss = wave_sum(ss);
    float rs = rsqrtf(ss * (1.f / 1024.f) + EPSN);
#pragma unroll
    for (int j = 0; j < 4; ++j) {
      float4 g = *(const float4*)(gpost + j * 256 + lane * 4);
      xv[j].x += yv[j].x * rs * g.x; xv[j].y += yv[j].y * rs * g.y; xv[j].z += yv[j].z * rs * g.z; xv[j].w += yv[j].w * rs * g.w;
      { f32x4 t_; t_[0] = xv[j].x; t_[1] = xv[j].y; t_[2] = xv[j].z; t_[3] = xv[j].w; __builtin_nontemporal_store(t_, (f32x4*)(xdst + j * 256 + lane * 4)); }
    }
  }
  if (NORM2) {
    float ss = 0.f;
#pragma unroll
    for (int j = 0; j < 4; ++j) ss += xv[j].x * xv[j].x + xv[j].y * xv[j].y + xv[j].z * xv[j].z + xv[j].w * xv[j].w;
    ss = wave_sum(ss);
    float rs = rsqrtf(ss * (1.f / 1024.f) + EPSN);
#pragma unroll
    for (int j = 0; j < 4; ++j) {
      float4 g = *(const float4*)(gnext + j * 256 + lane * 4);
      uint2 u; u.x = pack2(xv[j].x * rs * g.x, xv[j].y * rs * g.y); u.y = pack2(xv[j].z * rs * g.z, xv[j].w * rs * g.w);
      *(uint2*)(Hout + j * 256 + lane * 4) = u;
    }
  }
}

enum { EPI_F32 = 0, EPI_PROJ, EPI_XKV, EPI_QUP, EPI_KVUP, EPI_XQ, EPI_SWIGLU };

template <int EPI, int NB>
DI void gemm_epilogue(const Params& p, const f32x16 (&acc)[2][NB], int m0, int n0, int wm, int wn, int l31, int h) {
  bf16_t* PROJ = (bf16_t*)(p.ws + OFF_BIG);
#pragma unroll
  for (int i = 0; i < 2; ++i) {
    const int rb = m0 + wm * 64 + i * 32;
#pragma unroll
    for (int jn = 0; jn < NB; ++jn) {
      const int cb = n0 + wn * (32 * NB) + jn * 32;
      const int col = cb + l31;
      if (EPI == EPI_F32) {
        bf16_t* Y = (bf16_t*)(p.ws + OFF_Y);
#pragma unroll
        for (int r = 0; r < 16; ++r) { int row = rb + 8 * (r >> 2) + 4 * h + (r & 3); Y[(size_t)row * 1024 + col] = tobf(acc[i][jn][r]); }
      } else if (EPI == EPI_XQ) {
        const float sc = LOG2E * 0.0625f;
#pragma unroll
        for (int r = 0; r < 16; ++r) { int row = rb + 8 * (r >> 2) + 4 * h + (r & 3); PROJ[(size_t)row * 1024 + col] = tobf(acc[i][jn][r] * sc); }
      } else if (EPI == EPI_PROJ) {
        if (cb >= DIN) continue;
        if (cb >= 512 && cb < 768) {
          bf16_t* VtA = (bf16_t*)(p.ws + OFF_Y + 72 * MiB);
          int c2 = col - 512; int b = rb / SEQ, tok32 = rb % SEQ;
          bf16_t* rowp = VtA + ((size_t)(b * 4 + (c2 >> 6)) * 64 + (c2 & 63)) * SEQ;
#pragma unroll
          for (int g = 0; g < 4; ++g) store_vt(rowp, tok32, g, h, acc[i][jn][4 * g], acc[i][jn][4 * g + 1], acc[i][jn][4 * g + 2], acc[i][jn][4 * g + 3]);
        } else if (cb >= 1824) {
          bf16_t* VtC = (bf16_t*)(p.ws + OFF_Y + 104 * MiB);
          int c2 = col - 1824; int b = rb / SEQ, tok32 = rb % SEQ;
          bf16_t* rowp = VtC + ((size_t)(b * 2 + (c2 >> 6)) * 64 + (c2 & 63)) * SEQ;
#pragma unroll
          for (int g = 0; g < 4; ++g) store_vt(rowp, tok32, g, h, acc[i][jn][4 * g], acc[i][jn][4 * g + 1], acc[i][jn][4 * g + 2], acc[i][jn][4 * g + 3]);
        } else {
          float sc = 1.f;
          if (cb < 256) sc = LOG2E * 0.17677669529663687f;
          else if (cb >= 1184 && cb < 1696) sc = LOG2E * 0.125f;
#pragma unroll
          for (int r = 0; r < 16; ++r) { int row = rb + 8 * (r >> 2) + 4 * h + (r & 3); PROJ[(size_t)row * 2048 + col] = tobf(acc[i][jn][r] * sc); }
        }
      } else if (EPI == EPI_XKV) {
        if (cb < 1024) {
          bf16_t* KX = (bf16_t*)(p.ws + OFF_SM + 1 * MiB);
#pragma unroll
          for (int r = 0; r < 16; ++r) { int row = rb + 8 * (r >> 2) + 4 * h + (r & 3); KX[(size_t)row * 1024 + col] = tobf(acc[i][jn][r]); }
        } else {
          bf16_t* VtX = (bf16_t*)(p.ws + OFF_SM + 2 * MiB);
          int c2 = col - 1024; int b = rb >> 8, tok32 = rb & 255;
          bf16_t* rowp = VtX + ((size_t)(b * 4 + (c2 >> 8)) * 256 + (c2 & 255)) * 256;
#pragma unroll
          for (int g = 0; g < 4; ++g) store_vt(rowp, tok32, g, h, acc[i][jn][4 * g], acc[i][jn][4 * g + 1], acc[i][jn][4 * g + 2], acc[i][jn][4 * g + 3]);
        }
      } else if (EPI == EPI_QUP) {
        bf16_t* QB = (bf16_t*)(p.ws + OFF_Y + 24 * MiB);
        const float sc = LOG2E * 0.10206207261596575f;
        const bool ropeblk = (cb % 96) == 64;
        const float inv = rope_inv(l31 & 15);
#pragma unroll
        for (int r = 0; r < 16; ++r) {
          int row = rb + 8 * (r >> 2) + 4 * h + (r & 3);
          float v = acc[i][jn][r] * sc;
          if (ropeblk) {
            float other = __shfl_xor(v, 16);
            float ang = (float)p.pos[row] * inv;
            float s, c; sincos_red(ang, s, c);
            v = (l31 < 16) ? (v * c - other * s) : (other * s + v * c);
          }
          QB[(size_t)row * 384 + col] = tobf(v);
        }
      } else if (EPI == EPI_KVUP) {
        int head = cb >> 7, within = cb & 127;
        if (within < 64) {
          bf16_t* KB = (bf16_t*)(p.ws + OFF_Y + 48 * MiB);
#pragma unroll
          for (int r = 0; r < 16; ++r) { int row = rb + 8 * (r >> 2) + 4 * h + (r & 3); KB[(size_t)row * 384 + head * 96 + within + l31] = tobf(acc[i][jn][r]); }
        } else {
          bf16_t* VtB = (bf16_t*)(p.ws + OFF_Y + 88 * MiB);
          int dv = within - 64 + l31; int b = rb / SEQ, tok32 = rb % SEQ;
          bf16_t* rowp = VtB + ((size_t)(b * 4 + head) * 64 + dv) * SEQ;
#pragma unroll
          for (int g = 0; g < 4; ++g) store_vt(rowp, tok32, g, h, acc[i][jn][4 * g], acc[i][jn][4 * g + 1], acc[i][jn][4 * g + 2], acc[i][jn][4 * g + 3]);
        }
      } else if (EPI == EPI_SWIGLU) {
        if ((jn & 1) == 0) {
          bf16_t* F = (bf16_t*)(p.ws + OFF_BIG);
          const int oc = (cb >> 1) + l31;
#pragma unroll
          for (int r = 0; r < 16; ++r) {
            int row = rb + 8 * (r >> 2) + 4 * h + (r & 3);
            float g = acc[i][jn][r], u = acc[i][jn + 1 < NB ? jn + 1 : jn][r];
            float sg = g / (1.f + fexp2(-g * LOG2E));
            F[(size_t)row * DFF + oc] = tobf(sg * u);
          }
        }
      }
    }
  }
}

template <int EPI>
DI void gemm_phase(const Params& p, char* smem, const bf16_t* A, int lda, const bf16_t* Wt, int K, int nM, int nN, int xcdmap) {
  const int tid = opaque_tid(), lane = tid & 63, w = tid >> 6, l31 = lane & 31, h = lane >> 5;
  const int wm = w >> 1, wn = w & 1;
  bf16_t* sm = (bf16_t*)smem;
  constexpr int LDSROW = 72;
  constexpr int BUFE = 256 * LDSROW;
  const int nk = K >> 6;
  int total, start, step;
  const int xcd = blockIdx.x & 7;
  if (xcdmap) { total = (nM >> 3) * nN; start = blockIdx.x >> 3; step = gridDim.x >> 3; }
  else { total = nM * nN; start = blockIdx.x; step = gridDim.x; }
  for (int j = start; j < total; j += step) {
    int mt, nt;
    if (xcdmap) { int g = j / (8 * nN), r = j % (8 * nN); nt = r >> 3; mt = xcd * (nM >> 3) + g * 8 + (r & 7); }
    else { mt = j / nN; nt = j % nN; }
    const int m0 = mt * 128, n0 = nt * 128;
    const bf16_t* Ag = A + (size_t)m0 * lda;
    const bf16_t* Bg = Wt + (size_t)n0 * K;
    f32x16 acc[2][2];
#pragma unroll
    for (int i = 0; i < 2; ++i)
#pragma unroll
      for (int jn = 0; jn < 2; ++jn)
#pragma unroll
        for (int r = 0; r < 16; ++r) acc[i][jn][r] = 0.f;
    u32x4 ra0[4], rb0[4], ra1[4], rb1[4];
#define G_LOAD(RA, RB, kt_) do { _Pragma("unroll") for (int i_ = 0; i_ < 4; ++i_) { int c_ = tid + 256 * i_, row_ = c_ >> 3, ch_ = c_ & 7; \
      RA[i_] = *(const u32x4*)(Ag + (size_t)row_ * lda + (kt_) * 64 + ch_ * 8); RB[i_] = *(const u32x4*)(Bg + (size_t)row_ * K + (kt_) * 64 + ch_ * 8); } } while (0)
#define G_STORE(RA, RB, buf_) do { bf16_t* d_ = sm + (buf_) * BUFE; _Pragma("unroll") for (int i_ = 0; i_ < 4; ++i_) { int c_ = tid + 256 * i_, row_ = c_ >> 3, ch_ = c_ & 7; \
      *(u32x4*)(d_ + row_ * LDSROW + ch_ * 8) = RA[i_]; *(u32x4*)(d_ + (128 + row_) * LDSROW + ch_ * 8) = RB[i_]; } } while (0)
#define G_COMPUTE(buf_) do { const bf16_t* As_ = sm + (buf_) * BUFE; const bf16_t* Bs_ = As_ + 128 * LDSROW; \
      _Pragma("unroll") for (int ks_ = 0; ks_ < 4; ++ks_) { \
        bf16x8 a0_ = *(const bf16x8*)(As_ + (wm * 64 + l31) * LDSROW + ks_ * 16 + 8 * h); \
        bf16x8 a1_ = *(const bf16x8*)(As_ + (wm * 64 + 32 + l31) * LDSROW + ks_ * 16 + 8 * h); \
        bf16x8 b0_ = *(const bf16x8*)(Bs_ + (wn * 64 + l31) * LDSROW + ks_ * 16 + 8 * h); \
        bf16x8 b1_ = *(const bf16x8*)(Bs_ + (wn * 64 + 32 + l31) * LDSROW + ks_ * 16 + 8 * h); \
        acc[0][0] = mfma32(a0_, b0_, acc[0][0]); acc[0][1] = mfma32(a0_, b1_, acc[0][1]); \
        acc[1][0] = mfma32(a1_, b0_, acc[1][0]); acc[1][1] = mfma32(a1_, b1_, acc[1][1]); } } while (0)
    G_LOAD(ra0, rb0, 0);
    G_STORE(ra0, rb0, 0);
    G_LOAD(ra0, rb0, 1);
    if (nk > 2) G_LOAD(ra1, rb1, 2);
    __syncthreads();
    for (int kt = 0; kt < nk; kt += 2) {
      G_COMPUTE(0);
      G_STORE(ra0, rb0, 1);
      if (kt + 3 < nk) G_LOAD(ra0, rb0, kt + 3);
      __syncthreads();
      G_COMPUTE(1);
      if (kt + 2 < nk) G_STORE(ra1, rb1, 0);
      if (kt + 4 < nk) G_LOAD(ra1, rb1, kt + 4);
      __syncthreads();
    }
#undef G_LOAD
#undef G_STORE
#undef G_COMPUTE
    gemm_epilogue<EPI, 2>(p, acc, m0, n0, wm, wn, l31, h);
  }
}

template <int EPI>
DI void gemm_phase_w(const Params& p, char* smem, const bf16_t* A, int lda, const bf16_t* Wt, int K, int nM, int nN) {
  const int tid = opaque_tid(), lane = tid & 63, w = tid >> 6, l31 = lane & 31, h = lane >> 5;
  const int wm = w >> 1, wn = w & 1;
  bf16_t* sm = (bf16_t*)smem;
  constexpr int LR = 40;
  constexpr int BUFE = 384 * LR;
  const int nk = K >> 5;
  const int xcd = blockIdx.x & 7;
  const int total = (nM >> 3) * nN, start = blockIdx.x >> 3, step = gridDim.x >> 3;
  for (int j = start; j < total; j += step) {
    const int g = j / (8 * nN), r8 = j % (8 * nN);
    const int nt = r8 >> 3, mt = xcd * (nM >> 3) + g * 8 + (r8 & 7);
    const int m0 = mt * 128, n0 = nt * 256;
    const bf16_t* Ag = A + (size_t)m0 * lda;
    const bf16_t* Bg = Wt + (size_t)n0 * K;
    f32x16 acc[2][4];
#pragma unroll
    for (int i = 0; i < 2; ++i)
#pragma unroll
      for (int jn = 0; jn < 4; ++jn)
#pragma unroll
        for (int r = 0; r < 16; ++r) acc[i][jn][r] = 0.f;
    u32x4 ra[2], rb[4];
#define W_LOAD(kt_) do { \
      _Pragma("unroll") for (int i_ = 0; i_ < 2; ++i_) { int c_ = tid + 256 * i_, row_ = c_ >> 2, ch_ = c_ & 3; ra[i_] = *(const u32x4*)(Ag + (size_t)row_ * lda + (kt_) * 32 + ch_ * 8); } \
      _Pragma("unroll") for (int i_ = 0; i_ < 4; ++i_) { int c_ = tid + 256 * i_, row_ = c_ >> 2, ch_ = c_ & 3; rb[i_] = *(const u32x4*)(Bg + (size_t)row_ * K + (kt_) * 32 + ch_ * 8); } } while (0)
#define W_STORE(buf_) do { bf16_t* d_ = sm + (buf_) * BUFE; \
      _Pragma("unroll") for (int i_ = 0; i_ < 2; ++i_) { int c_ = tid + 256 * i_, row_ = c_ >> 2, ch_ = c_ & 3; *(u32x4*)(d_ + row_ * LR + ch_ * 8) = ra[i_]; } \
      _Pragma("unroll") for (int i_ = 0; i_ < 4; ++i_) { int c_ = tid + 256 * i_, row_ = c_ >> 2, ch_ = c_ & 3; *(u32x4*)(d_ + (128 + row_) * LR + ch_ * 8) = rb[i_]; } } while (0)
    W_LOAD(0); W_STORE(0);
    __syncthreads();
    for (int kt = 0; kt < nk; ++kt) {
      const bool more = (kt + 1 < nk);
      if (more) W_LOAD(kt + 1);
      const bf16_t* As = sm + (kt & 1) * BUFE;
      const bf16_t* Bs = As + 128 * LR;
#pragma unroll
      for (int ks = 0; ks < 2; ++ks) {
        bf16x8 a0 = *(const bf16x8*)(As + (wm * 64 + l31) * LR + ks * 16 + 8 * h);
        bf16x8 a1 = *(const bf16x8*)(As + (wm * 64 + 32 + l31) * LR + ks * 16 + 8 * h);
#pragma unroll
        for (int jn = 0; jn < 4; ++jn) {
          bf16x8 b = *(const bf16x8*)(Bs + (wn * 128 + jn * 32 + l31) * LR + ks * 16 + 8 * h);
          acc[0][jn] = mfma32(a0, b, acc[0][jn]);
          acc[1][jn] = mfma32(a1, b, acc[1][jn]);
        }
      }
      if (more) W_STORE((kt + 1) & 1);
      __syncthreads();
    }
#undef W_LOAD
#undef W_STORE
    gemm_epilogue<EPI, 4>(p, acc, m0, n0, wm, wn, l31, h);
  }
}

#define RAW_BARRIER() do { asm volatile("s_waitcnt lgkmcnt(0)" ::: "memory"); __builtin_amdgcn_s_barrier(); } while (0)
typedef __attribute__((address_space(3))) unsigned lds_u32;
template <int EPI>
DI void gemm_phase_g(const Params& p, char* smem, const bf16_t* A, int lda, const bf16_t* Wt, int K, int nM, int nN) {
  const int tid = opaque_tid(), lane = tid & 63, w = tid >> 6, l31 = lane & 31, h = lane >> 5;
  const int wm = w >> 1, wn = w & 1;
  constexpr int STAGE = 24576;
  const int nk = K >> 5;
  const int xcd = blockIdx.x & 7;
  const int total = (nM >> 3) * nN, start = blockIdx.x >> 3, step = gridDim.x >> 3;
  const int rip = lane >> 2, gch = (lane & 3) ^ ((lane >> 4) & 3);
  const int fsw = (l31 >> 2) & 3;
  const int lo0 = (l31 >> 4) * 1024 + (l31 & 15) * 64 + ((h ^ fsw) * 16);
  const int lo1 = (l31 >> 4) * 1024 + (l31 & 15) * 64 + (((2 + h) ^ fsw) * 16);
  const int wuni = __builtin_amdgcn_readfirstlane(w);
  const unsigned ldsA = (unsigned)(size_t)smem + (unsigned)(wm * 4096);
  const unsigned ldsB = (unsigned)(size_t)smem + 8192u + (unsigned)(wn * 8192);
  for (int j = start; j < total; j += step) {
    const int g = j / (8 * nN), r8 = j % (8 * nN);
    const int nt = r8 >> 3, mt = xcd * (nM >> 3) + g * 8 + (r8 & 7);
    const int m0 = mt * 128, n0 = nt * 256;
    const bf16_t* srcA0 = A + (size_t)(m0 + 16 * w + rip) * lda + gch * 8;
    const bf16_t* srcB0 = Wt + (size_t)(n0 + 16 * w + rip) * K + gch * 8;
    f32x16 acc[2][4];
#pragma unroll
    for (int i = 0; i < 2; ++i)
#pragma unroll
      for (int jn = 0; jn < 4; ++jn)
#pragma unroll
        for (int r = 0; r < 16; ++r) acc[i][jn][r] = 0.f;
#define GLDS_STEP(kt_, st_) do { \
      char* sb_ = smem + (st_) * STAGE + wuni * 1024; \
      _Pragma("unroll") for (int i_ = 0; i_ < 2; ++i_) \
        __builtin_amdgcn_global_load_lds((const unsigned*)(srcA0 + (size_t)(64 * i_) * lda + (kt_) * 32), (lds_u32*)(sb_ + i_ * 4096), 16, 0, 0); \
      _Pragma("unroll") for (int i_ = 0; i_ < 4; ++i_) \
        __builtin_amdgcn_global_load_lds((const unsigned*)(srcB0 + (size_t)(64 * i_) * K + (kt_) * 32), (lds_u32*)(sb_ + 8192 + i_ * 4096), 16, 0, 0); \
    } while (0)
    GLDS_STEP(0, 0);
    GLDS_STEP(1, 1);
    int st = 0;
    for (int kt = 0; kt < nk; ++kt) {
      if (kt + 1 < nk) asm volatile("s_waitcnt vmcnt(6)" ::: "memory");
      else asm volatile("s_waitcnt vmcnt(0)" ::: "memory");
      RAW_BARRIER();
      if (kt + 2 < nk) { const int st2 = (st >= 1) ? st - 1 : 2; GLDS_STEP(kt + 2, st2); }
      const unsigned sa = ldsA + st * STAGE, sbb = ldsB + st * STAGE;
      bf16x8 fa0, fa1, fb0, fb1, fb2, fb3, ga0, ga1, gb0, gb1, gb2, gb3;
      asm volatile(
          "ds_read_b128 %0, %12\n\tds_read_b128 %1, %12 offset:2048\n\t"
          "ds_read_b128 %2, %13\n\tds_read_b128 %3, %13 offset:2048\n\tds_read_b128 %4, %13 offset:4096\n\tds_read_b128 %5, %13 offset:6144\n\t"
          "ds_read_b128 %6, %14\n\tds_read_b128 %7, %14 offset:2048\n\t"
          "ds_read_b128 %8, %15\n\tds_read_b128 %9, %15 offset:2048\n\tds_read_b128 %10, %15 offset:4096\n\tds_read_b128 %11, %15 offset:6144\n\t"
          "s_waitcnt lgkmcnt(6)"
          : "=&v"(fa0), "=&v"(fa1), "=&v"(fb0), "=&v"(fb1), "=&v"(fb2), "=&v"(fb3),
            "=&v"(ga0), "=&v"(ga1), "=&v"(gb0), "=&v"(gb1), "=&v"(gb2), "=&v"(gb3)
          : "v"(sa + lo0), "v"(sbb + lo0), "v"(sa + lo1), "v"(sbb + lo1)
          : "memory");
      __builtin_amdgcn_s_setprio(1);
      acc[0][0] = mfma32(fa0, fb0, acc[0][0]); acc[1][0] = mfma32(fa1, fb0, acc[1][0]);
      acc[0][1] = mfma32(fa0, fb1, acc[0][1]); acc[1][1] = mfma32(fa1, fb1, acc[1][1]);
      acc[0][2] = mfma32(fa0, fb2, acc[0][2]); acc[1][2] = mfma32(fa1, fb2, acc[1][2]);
      acc[0][3] = mfma32(fa0, fb3, acc[0][3]); acc[1][3] = mfma32(fa1, fb3, acc[1][3]);
      asm volatile("s_waitcnt lgkmcnt(0)" : "+v"(ga0), "+v"(ga1), "+v"(gb0), "+v"(gb1), "+v"(gb2), "+v"(gb3) : : "memory");
      acc[0][0] = mfma32(ga0, gb0, acc[0][0]); acc[1][0] = mfma32(ga1, gb0, acc[1][0]);
      acc[0][1] = mfma32(ga0, gb1, acc[0][1]); acc[1][1] = mfma32(ga1, gb1, acc[1][1]);
      acc[0][2] = mfma32(ga0, gb2, acc[0][2]); acc[1][2] = mfma32(ga1, gb2, acc[1][2]);
      acc[0][3] = mfma32(ga0, gb3, acc[0][3]); acc[1][3] = mfma32(ga1, gb3, acc[1][3]);
      __builtin_amdgcn_s_setprio(0);
      st = (st == 2) ? 0 : st + 1;
    }
    __syncthreads();
#undef GLDS_STEP
    gemm_epilogue<EPI, 4>(p, acc, m0, n0, wm, wn, l31, h);
  }
}

template <int DQK, int NMAP, int DV, int KIND, bool PREFETCH, bool AUG, bool FAST>
DI void attn_tiles(char* smem, int tid, const bf16_t* Kp, int ldk, const bf16_t* Vt, int ldv, int kt0, int kt1,
                   unsigned long long tm0, unsigned long long tm1, unsigned long long tm2, unsigned long long tm3,
                   const int* posk, const float* pmm, float slope2, float pq, int qidx, float qmin,
                   const bf16x8 (&qf)[NMAP][DQK / 16], bf16x8 qaugP,
                   f32x16 (&O)[NMAP][DV / 32], float (&mrun)[NMAP], float (&lrun)[NMAP]) {
  constexpr bool USEMASK = (KIND == 0);
  constexpr bool LSUM = (KIND == 0) && AUG && FAST;
  constexpr bool SEQM = ((KIND == 1) && FAST);
  constexpr bool QLDS = (KIND == 0);
  constexpr bool POS = (!AUG) && (KIND == 0 || KIND == 2);
  constexpr int KAUG = (KIND == 0) ? 16 : 0;
  constexpr bool KSHARE = (KIND == 1);
  constexpr int KD = KSHARE ? DQK : NMAP * DQK;
  constexpr int KROW = KD + KAUG + 8, VROW = 72;
  constexpr int KBYTES = 64 * KROW * 2, VBYTES = DV * VROW * 2, BUFBYTES = KBYTES + VBYTES + 512;
  constexpr int CH = KD / 8, KCH = CH / 4, VCH = DV / 32;
  constexpr int NKS = DQK / 16, NDB = DV / 32;
  const int lane = tid & 63, l31 = lane & 31, h = lane >> 5;

  u32x4 kreg[KCH], vreg[VCH]; float pkreg = 0.f, kmnreg = 0.f;
#define LOAD_REGS(kt_) do { int tl_ = tid; if (KIND == 1) asm volatile("" : "+v"(tl_));   \
    _Pragma("unroll") for (int i_ = 0; i_ < KCH; ++i_) { int c_ = tl_ + 256 * i_, row_ = c_ / CH, ch_ = c_ % CH; kreg[i_] = *(const u32x4*)(Kp + (size_t)((kt_) * 64 + row_) * ldk + ch_ * 8); } \
    _Pragma("unroll") for (int i_ = 0; i_ < VCH; ++i_) { int c_ = tl_ + 256 * i_, row_ = c_ >> 3, ch_ = c_ & 7; vreg[i_] = *(const u32x4*)(Vt + (size_t)row_ * ldv + (kt_) * 64 + ch_ * 8); } \
    if (POS || AUG) { pkreg = (float)posk[(kt_) * 64 + (tid & 63)]; } \
    if (AUG) { kmnreg = pmm[2 * (kt_)]; } } while (0)
#define COPY_TILE(kt_) do { \
    bf16_t* Ks_ = (bf16_t*)smem; bf16_t* Vs_ = (bf16_t*)(smem + KBYTES); \
    _Pragma("unroll") for (int i0_ = 0; i0_ < KCH; i0_ += 4) { \
      u32x4 t_[4]; \
      _Pragma("unroll") for (int i_ = 0; i_ < 4; ++i_) if (i0_ + i_ < KCH) { int c_ = tid + 256 * (i0_ + i_), row_ = c_ / CH, ch_ = c_ % CH; t_[i_] = *(const u32x4*)(Kp + (size_t)((kt_) * 64 + row_) * ldk + ch_ * 8); } \
      _Pragma("unroll") for (int i_ = 0; i_ < 4; ++i_) if (i0_ + i_ < KCH) { int c_ = tid + 256 * (i0_ + i_), row_ = c_ / CH, ch_ = c_ % CH; *(u32x4*)(Ks_ + row_ * KROW + ch_ * 8) = t_[i_]; } \
      __builtin_amdgcn_sched_barrier(0); } \
    _Pragma("unroll") for (int i_ = 0; i_ < VCH; ++i_) { int c_ = tid + 256 * i_, row_ = c_ >> 3, ch_ = c_ & 7; u32x4 t_ = *(const u32x4*)(Vt + (size_t)row_ * ldv + (kt_) * 64 + ch_ * 8); *(u32x4*)(Vs_ + row_ * VROW + ch_ * 8) = t_; } \
    } while (0)
#define STORE_REGS(buf_) do { int ts_ = tid;  \
    char* base_ = smem + (buf_) * BUFBYTES; \
    bf16_t* Ks_ = (bf16_t*)base_; bf16_t* Vs_ = (bf16_t*)(base_ + KBYTES); float* Ps_ = (float*)(base_ + KBYTES + VBYTES); \
    _Pragma("unroll") for (int i_ = 0; i_ < KCH; ++i_) { int c_ = ts_ + 256 * i_, row_ = c_ / CH, ch_ = c_ % CH; *(u32x4*)(Ks_ + row_ * KROW + ch_ * 8) = kreg[i_]; } \
    _Pragma("unroll") for (int i_ = 0; i_ < VCH; ++i_) { int c_ = ts_ + 256 * i_, row_ = c_ >> 3, ch_ = c_ & 7; *(u32x4*)(Vs_ + row_ * VROW + ch_ * 8) = vreg[i_]; } \
    if (POS) { if (tid < 64) Ps_[tid] = pkreg; } \
    if (AUG) { if (tid < 64) { \
        const float b_ = slope2 * (pkreg - kmnreg); const float bh_ = frombf(tobf(b_)), bm_ = frombf(tobf(b_ - bh_)), bl_ = frombf(tobf(b_ - bh_ - bm_)); \
        const float c_ = (kmnreg <= qmin) ? -slope2 * (qmin - kmnreg) : slope2 * (qmin - kmnreg); \
        const float ch_ = frombf(tobf(c_)), cm_ = frombf(tobf(c_ - ch_)), cl_ = frombf(tobf(c_ - ch_ - cm_)); \
        uint32_t on2_ = 0x3f803f80u, zz2_ = 0u; asm volatile("" : "+v"(on2_), "+v"(zz2_));     \
        u32x4 a0_, a1_; a0_[0] = on2_; a0_[1] = pack2(1.f, bh_); a0_[2] = pack2(bm_, bl_); a0_[3] = on2_; \
        a1_[0] = pack2(1.f, ch_); a1_[1] = pack2(cm_, cl_); a1_[2] = zz2_; a1_[3] = zz2_; \
        *(u32x4*)(Ks_ + tid * KROW + KD) = a0_; *(u32x4*)(Ks_ + tid * KROW + KD + 8) = a1_; \
        if (tid == 0) Ps_[64] = kmnreg; } } } while (0)

  int ntiles, glin = kt0, gword = 0; unsigned long long gcur = tm0;
  if (USEMASK) ntiles = __builtin_popcountll(tm0) + __builtin_popcountll(tm1) + __builtin_popcountll(tm2) + __builtin_popcountll(tm3);
  else ntiles = kt1 - kt0;
#define NEXT_TILE(dst_) do { if (USEMASK) { \
      while (gcur == 0ull && gword < 3) { ++gword; gcur = (gword == 1) ? tm1 : ((gword == 2) ? tm2 : tm3); } \
      dst_ = gword * 64 + (int)__builtin_ctzll(gcur); gcur &= gcur - 1ull; } else { dst_ = glin++; } } while (0)
  if (ntiles <= 0) return;
  int ktc; NEXT_TILE(ktc);

  __syncthreads();
  f32x16 Lacc[NMAP]; bf16x8 aones = {0, 0, 0, 0, 0, 0, 0, 0};
  if (LSUM) {
    uint32_t on_ = (l31 == 0) ? 0x3f803f80u : 0u; asm volatile("" : "+v"(on_));
    u32x4 ou; ou[0] = ou[1] = ou[2] = ou[3] = on_; aones = __builtin_bit_cast(bf16x8, ou);
#pragma unroll
    for (int m = 0; m < NMAP; ++m) {
      const float lt = lrun[m] + __shfl_xor(lrun[m], 32);
#pragma unroll
      for (int r = 0; r < 16; ++r) Lacc[m][r] = 0.f;
      Lacc[m][0] = h ? 0.f : lt;
      lrun[m] = 0.f;
    }
  }
  bool seeded = false;
  if (AUG) {
    seeded = (__builtin_amdgcn_ballot_w64(mrun[0] < -1e29f) == 0ull);
    if (seeded) {
#pragma unroll
      for (int m = 0; m < NMAP; ++m) {
        const float nm = -mrun[m];
        const float nh = frombf(tobf(nm)), nmd = frombf(tobf(nm - nh)), nl = frombf(tobf(nm - nh - nmd));
        uint32_t* qap = (uint32_t*)(smem + 2 * BUFBYTES + 128 * 72 * 2 + m * 4096 + tid * 16);
        if (h) qap[0] = pack2(nl, 1.f); else qap[3] = pack2(nh, nmd);
      }
    }
  }
  if (PREFETCH) { LOAD_REGS(ktc); STORE_REGS(0); } else { COPY_TILE(ktc); }
  __syncthreads();

#pragma unroll 1
  for (int it = 0; it < ntiles; ++it) {
    const int cur = PREFETCH ? (it & 1) : 0;
    const bool more = (it + 1 < ntiles);
    int ktn = ktc;
    if (more) NEXT_TILE(ktn);
    if (PREFETCH && more) LOAD_REGS(ktn);
    {
      const char* base = smem + cur * BUFBYTES;
      const bf16_t* Ks = (const bf16_t*)base; const bf16_t* Vs = (const bf16_t*)(base + KBYTES); const float* Ps = (const float*)(base + KBYTES + VBYTES);
      const float cbias = 0.f; uint32_t sgn = 0u;
      if (AUG) {
        const float kmn = Ps[64];
        const bool left = (kmn <= qmin);
        sgn = (left || h) ? 0u : 0x80008000u;
      }
#pragma unroll
      for (int mm = 0; mm < (SEQM ? NMAP : 1); ++mm) {
      const int mlo = SEQM ? mm : 0, mhi = SEQM ? mm + 1 : NMAP;
      f32x16 SS[NMAP][2];
#pragma unroll
      for (int m = mlo; m < mhi; ++m) {
#pragma unroll
        for (int mb = 0; mb < 2; ++mb)
#pragma unroll
          for (int r = 0; r < 16; ++r) SS[m][mb][r] = 0.f;
#pragma unroll
        for (int ks = 0; ks < NKS; ++ks) {
          bf16x8 a0 = *(const bf16x8*)(Ks + (l31) * KROW + (KSHARE ? 0 : m * DQK) + ks * 16 + 8 * h);
          bf16x8 a1 = *(const bf16x8*)(Ks + (32 + l31) * KROW + (KSHARE ? 0 : m * DQK) + ks * 16 + 8 * h);
          bf16x8 qv;
          if (QLDS) qv = *(const bf16x8*)((const bf16_t*)(smem + 2 * BUFBYTES) + ((tid >> 6) * 32 + l31) * 72 + m * DQK + ks * 16 + 8 * h);
          else if (KSHARE && m == 1) qv = *(const bf16x8*)((const bf16_t*)(smem + 2 * BUFBYTES) + ((tid >> 6) * 32 + l31) * (DQK + 8) + ks * 16 + 8 * h);
          else qv = qf[m][ks];
          SS[m][0] = mfma32(a0, qv, SS[m][0]);
          SS[m][1] = mfma32(a1, qv, SS[m][1]);
          if ((ks & 1) == 1) __builtin_amdgcn_sched_barrier(0);
        }
        if (AUG) {
          bf16x8 a0 = *(const bf16x8*)(Ks + (l31) * KROW + KD + 8 * h);
          bf16x8 a1 = *(const bf16x8*)(Ks + (32 + l31) * KROW + KD + 8 * h);
          u32x4 qu = *(const u32x4*)(smem + 2 * BUFBYTES + 128 * 72 * 2 + m * 4096 + tid * 16);
          qu[0] ^= sgn; qu[1] ^= sgn; qu[2] ^= sgn;
          const bf16x8 qa = __builtin_bit_cast(bf16x8, qu);
          SS[m][0] = mfma32(a0, qa, SS[m][0]);
          SS[m][1] = mfma32(a1, qa, SS[m][1]);
        }
        __builtin_amdgcn_sched_barrier(0);
      }
#pragma unroll
      for (int m = mlo; m < mhi; ++m) {
        f32x16 (&S)[2] = SS[m];
        if (POS) {
#pragma unroll
          for (int mb = 0; mb < 2; ++mb)
#pragma unroll
            for (int g = 0; g < 4; ++g) {
              float4 pk4 = *(const float4*)(Ps + mb * 32 + 8 * g + 4 * h);
#pragma unroll
              for (int i = 0; i < 4; ++i) {
                const float pkv = (i == 0) ? pk4.x : (i == 1) ? pk4.y : (i == 2) ? pk4.z : pk4.w;
                float s = S[mb][4 * g + i] - slope2 * fabsf(pq - pkv);
                if (KIND == 2) {
                  int kidx = ktc * 64 + mb * 32 + 8 * g + 4 * h + i;
                  int dd = kidx - qidx; dd = dd < 0 ? -dd : dd;
                  if (dd > 128) s = -1e30f;
                }
                S[mb][4 * g + i] = s;
              }
            }
        }
        __builtin_amdgcn_sched_barrier(0);
        float mx = S[0][0];
        if (!FAST) {
#pragma unroll
          for (int mb = 0; mb < 2; ++mb)
#pragma unroll
            for (int r = 0; r < 16; ++r) mx = fmaxf(mx, S[mb][r]);
        }
        float rs = 0.f;
        if (FAST) {
#pragma unroll
          for (int mb = 0; mb < 2; ++mb)
#pragma unroll
            for (int r = 0; r < 16; ++r) {
              float pv = fexp2(S[mb][r]); S[mb][r] = pv; if (!LSUM) rs += pv;
              if ((r & 7) == 7) __builtin_amdgcn_sched_barrier(0);
            }
        } else if (AUG) {
          mx = half_max(mx) + cbias;
          bool fix = false; float dlt = 0.f;
          if (it == 0 && !seeded) { dlt = mx; mrun[m] = mx; fix = true; }
          else if (__builtin_amdgcn_ballot_w64(mx > 0.f) != 0ull) {
            dlt = fmaxf(mx, 0.f);
            const float alpha = fexp2(-dlt);
            mrun[m] += dlt;
            lrun[m] *= alpha;
#pragma unroll
            for (int db = 0; db < NDB; ++db)
#pragma unroll
              for (int r = 0; r < 16; ++r) O[m][db][r] *= alpha;
            fix = true;
          }
          if (fix) {
#pragma unroll
            for (int mb = 0; mb < 2; ++mb)
#pragma unroll
              for (int r = 0; r < 16; ++r) S[mb][r] -= dlt;
            const float nm = -mrun[m];
            const float nh = frombf(tobf(nm)), nmd = frombf(tobf(nm - nh)), nl = frombf(tobf(nm - nh - nmd));
            uint32_t* qap = (uint32_t*)(smem + 2 * BUFBYTES + 128 * 72 * 2 + m * 4096 + tid * 16);
            if (h) qap[0] = pack2(nl, 1.f); else qap[3] = pack2(nh, nmd);
          }
#pragma unroll
          for (int mb = 0; mb < 2; ++mb)
#pragma unroll
            for (int r = 0; r < 16; ++r) { float pv = fexp2(S[mb][r]); S[mb][r] = pv; rs += pv; }
        } else {
          mx = half_max(mx) + cbias;
          if (__builtin_amdgcn_ballot_w64(mx > mrun[m]) != 0ull) {
            const float mnew = fmaxf(mrun[m], mx);
            const float alpha = fexp2(mrun[m] - mnew);
            mrun[m] = mnew;
            lrun[m] *= alpha;
#pragma unroll
            for (int db = 0; db < NDB; ++db)
#pragma unroll
              for (int r = 0; r < 16; ++r) O[m][db][r] *= alpha;
          }
          const float msub = mrun[m] - cbias;
#pragma unroll
          for (int mb = 0; mb < 2; ++mb)
#pragma unroll
            for (int r = 0; r < 16; ++r) { float pv = fexp2(S[mb][r] - msub); S[mb][r] = pv; rs += pv; }
        }
        lrun[m] += rs;
        bf16x8 pf[4];
#pragma unroll
        for (int mb = 0; mb < 2; ++mb)
#pragma unroll
          for (int s = 0; s < 2; ++s) {
            u32x4 u;
            u[0] = pack2(S[mb][8 * s + 0], S[mb][8 * s + 1]); u[1] = pack2(S[mb][8 * s + 2], S[mb][8 * s + 3]);
            u[2] = pack2(S[mb][8 * s + 4], S[mb][8 * s + 5]); u[3] = pack2(S[mb][8 * s + 6], S[mb][8 * s + 7]);
            pf[mb * 2 + s] = __builtin_bit_cast(bf16x8, u);
          }
        if (LSUM) {
#pragma unroll
          for (int kk = 0; kk < 4; ++kk) Lacc[m] = mfma32(aones, pf[kk], Lacc[m]);
        }
#pragma unroll
        for (int db = 0; db < NDB; ++db) {
#pragma unroll
          for (int kk = 0; kk < 4; ++kk) {
            bf16x8 a = *(const bf16x8*)(Vs + (db * 32 + l31) * VROW + kk * 16 + 8 * h);
            O[m][db] = mfma32(a, pf[kk], O[m][db]);
          }
          __builtin_amdgcn_sched_barrier(0);
        }
      }
      }
    }
    if (PREFETCH) {
      if (more) STORE_REGS(cur ^ 1);
      __syncthreads();
    } else {
      __syncthreads();
      if (more) { COPY_TILE(ktn); __syncthreads(); }
    }
    ktc = ktn;
  }
  if (LSUM) {
#pragma unroll
    for (int m = 0; m < NMAP; ++m) lrun[m] = h ? 0.f : Lacc[m][0];
  }
}
#undef NEXT_TILE
#undef LOAD_REGS
#undef COPY_TILE
#undef STORE_REGS

template <int DQK, int NMAP, int DV, int KIND, bool PREFETCH, bool FAST>
DI bool attn_unit(char* smem, const bf16_t* Qp, int ldq, const bf16_t* Kp, int ldk, const bf16_t* Vt, int ldv,
                  int kt0, int kt1, const int* posq, const int* posk, const float* pmm, float slope2, float sink2, int q0idx,
                  float lam, const float* headg, float outscale, bf16_t* Op, int ldo) {
  constexpr int NKS = DQK / 16, NDB = DV / 32;
  const int tid = opaque_tid(), lane = tid & 63, w = tid >> 6, l31 = lane & 31, h = lane >> 5;
  constexpr bool KSHARE = (KIND == 1);
  const int qr = KSHARE ? (64 * w + l31) : (32 * w + l31);

  bf16x8 qf[NMAP][NKS];
  {
    const bf16_t* qrow = Qp + (size_t)qr * ldq;
#pragma unroll
    for (int m = 0; m < NMAP; ++m)
#pragma unroll
      for (int ks = 0; ks < NKS; ++ks) qf[m][ks] = *(const bf16x8*)(qrow + (KSHARE ? (size_t)(32 * m) * ldq : (size_t)(m * DQK)) + ks * 16 + 8 * h);
  }
  float pq = 0.f;
  if (KIND == 0 || KIND == 2) pq = (float)posq[qr];
  const int qidx = q0idx + qr;

  f32x16 O[NMAP][NDB];
  float mrun[NMAP], lrun[NMAP];
#pragma unroll
  for (int m = 0; m < NMAP; ++m) {
#pragma unroll
    for (int db = 0; db < NDB; ++db)
#pragma unroll
      for (int r = 0; r < 16; ++r) O[m][db][r] = 0.f;
    if (KIND == 2) { mrun[m] = sink2; lrun[m] = (h == 0) ? 1.f : 0.f; }
    else { mrun[m] = -1e30f; lrun[m] = 0.f; }
  }

  bf16x8 qz = {0, 0, 0, 0, 0, 0, 0, 0};
  if (KSHARE) {
    constexpr int BUFB1 = 64 * (DQK + 8) * 2 + DV * 72 * 2 + 512;
    bf16_t* Qs = (bf16_t*)(smem + 2 * BUFB1) + (w * 32 + l31) * (DQK + 8);
#pragma unroll
    for (int ks = 0; ks < NKS; ++ks) { *(bf16x8*)(Qs + ks * 16 + 8 * h) = qf[NMAP - 1][ks]; qf[NMAP - 1][ks] = qz; }
  }
  if (KIND == 0) {
    {
      constexpr int BUFB0 = 64 * (NMAP * DQK + 16 + 8) * 2 + DV * 72 * 2 + 512;
      bf16_t* Qs = (bf16_t*)(smem + 2 * BUFB0) + (w * 32 + l31) * 72;
#pragma unroll
      for (int m = 0; m < NMAP; ++m)
#pragma unroll
        for (int ks = 0; ks < NKS; ++ks) { *(bf16x8*)(Qs + m * DQK + ks * 16 + 8 * h) = qf[m][ks]; qf[m][ks] = qz; }
    }
    float bmin = fminf((float)posq[lane], (float)posq[lane + 64]), bmax = fmaxf((float)posq[lane], (float)posq[lane + 64]);
#pragma unroll
    for (int o = 32; o >= 1; o >>= 1) { bmin = fminf(bmin, __shfl_xor(bmin, o)); bmax = fmaxf(bmax, __shfl_xor(bmax, o)); }
    unsigned long long mix[4];
#pragma unroll
    for (int j = 0; j < 4; ++j) {
      const int t = j * 64 + lane;
      const float kmn = pmm[2 * t], kmx = pmm[2 * t + 1];
      mix[j] = __builtin_amdgcn_ballot_w64((kmx > bmin) && (kmn < bmax));
    }
    const float a = -slope2 * (pq - bmin);
    const float ah = frombf(tobf(a)), am = frombf(tobf(a - ah)), al = frombf(tobf(a - ah - am));
    u32x4 up;
    if (h) { up[0] = pack2(0.f, 1.f); up[1] = pack2(1.f, 1.f); up[2] = 0u; up[3] = 0u; }
    else   { up[0] = pack2(ah, am); up[1] = pack2(al, 1.f); up[2] = pack2(1.f, 1.f); up[3] = 0u; }
    {
      constexpr int BUFB0 = 64 * (NMAP * DQK + 16 + 8) * 2 + DV * 72 * 2 + 512;
#pragma unroll
      for (int m = 0; m < NMAP; ++m) *(u32x4*)(smem + 2 * BUFB0 + 128 * 72 * 2 + m * 4096 + tid * 16) = up;
    }
    const bf16x8 qaugP = qz;
    attn_tiles<DQK, NMAP, DV, KIND, PREFETCH, false, false>(smem, tid, Kp, ldk, Vt, ldv, kt0, kt1, mix[0], mix[1], mix[2], mix[3],
                                                     posk, pmm, slope2, pq, qidx, bmin, qf, qz, O, mrun, lrun);
    attn_tiles<DQK, NMAP, DV, KIND, PREFETCH, true, FAST>(smem, tid, Kp, ldk, Vt, ldv, kt0, kt1, ~mix[0], ~mix[1], ~mix[2], ~mix[3],
                                                    posk, pmm, slope2, pq, qidx, bmin, qf, qaugP, O, mrun, lrun);
  } else {
    attn_tiles<DQK, NMAP, DV, KIND, PREFETCH, false, FAST>(smem, tid, Kp, ldk, Vt, ldv, kt0, kt1, 0ull, 0ull, 0ull, 0ull,
                                                     posk, pmm, slope2, pq, qidx, 0.f, qf, qz, O, mrun, lrun);
  }

  if (FAST) {
    bool bad = false;
#pragma unroll
    for (int m = 0; m < NMAP; ++m) { const float lt = lrun[m] + __shfl_xor(lrun[m], 32); bad = bad || !(lt > 9.0e-13f && lt < 1.0e18f); }
    __shared__ unsigned sflag[4];
    const unsigned long long bm = __builtin_amdgcn_ballot_w64(bad);
    if (lane == 0) sflag[w] = (bm != 0ull) ? 1u : 0u;
    __syncthreads();
    const unsigned anybad = sflag[0] | sflag[1] | sflag[2] | sflag[3];
    __syncthreads();
    if (anybad) return true;
  }
  float inv[NMAP];
#pragma unroll
  for (int m = 0; m < NMAP; ++m) { float lt = lrun[m] + __shfl_xor(lrun[m], 32); inv[m] = 1.f / lt; }
  bf16_t* orow = Op + (size_t)qr * ldo;
  if (KIND == 0) {
    float ss = 0.f;
#pragma unroll
    for (int db = 0; db < NDB; ++db)
#pragma unroll
      for (int r = 0; r < 16; ++r) {
        float o = O[0][db][r] * inv[0] - lam * (O[NMAP - 1][db][r] * inv[NMAP - 1]);
        O[0][db][r] = o; ss += o * o;
      }
    ss += __shfl_xor(ss, 32);
    const float rs = rsqrtf(ss * (1.f / 64.f) + EPSN) * outscale;
#pragma unroll
    for (int db = 0; db < NDB; ++db)
#pragma unroll
      for (int g = 0; g < 4; ++g) {
        int dv = db * 32 + 8 * g + 4 * h;
        float4 gg = *(const float4*)(headg + dv);
        uint2 u; u.x = pack2(O[0][db][4 * g] * rs * gg.x, O[0][db][4 * g + 1] * rs * gg.y);
        u.y = pack2(O[0][db][4 * g + 2] * rs * gg.z, O[0][db][4 * g + 3] * rs * gg.w);
        *(uint2*)(orow + dv) = u;
      }
  } else {
#pragma unroll
    for (int m = 0; m < (KSHARE ? NMAP : 1); ++m)
#pragma unroll
      for (int db = 0; db < NDB; ++db)
#pragma unroll
        for (int g = 0; g < 4; ++g) {
          int dv = db * 32 + 8 * g + 4 * h;
          uint2 u; u.x = pack2(O[m][db][4 * g] * inv[m], O[m][db][4 * g + 1] * inv[m]);
          u.y = pack2(O[m][db][4 * g + 2] * inv[m], O[m][db][4 * g + 3] * inv[m]);
          *(uint2*)(orow + (size_t)(32 * m) * ldo + dv) = u;
        }
  }
  return false;
}
DI void phase_rows_init_or_res3(const Params& p, int l, bool init, char* smem) {
  const int tid_ = opaque_tid(); const int lane = tid_ & 63, w = tid_ >> 6;
  bf16_t* H = (bf16_t*)(p.ws + OFF_H);
  const bf16_t* Y = (const bf16_t*)(p.ws + OFF_Y);
  const int nl = init ? 0 : l + 1;
  for (int row = blockIdx.x * 4 + w; row < NTOK; row += gridDim.x * 4) {
    size_t ro = (size_t)row * 1024;
    if (init) row_op<false, true>(p.x_in + ro, nullptr, nullptr, nullptr, p.g_mix_pre, H + ro, lane);
    else if (l < DEPTH - 1) row_op<true, true>(p.xres + ro, Y + ro, p.g_ffn_post + l * 1024, p.xres + ro, p.g_mix_pre + (l + 1) * 1024, H + ro, lane);
    else row_op<true, false>(p.xres + ro, Y + ro, p.g_ffn_post + l * 1024, p.xres + ro, nullptr, nullptr, lane);
  }
  if (init) {
    float* PMM = (float*)(p.ws + OFF_SM + 3 * MiB);
    for (int t = blockIdx.x * 4 + w; t < NTOK / 64; t += gridDim.x * 4) {
      float v = (float)p.pos[t * 64 + lane]; float mn = v, mx = v;
#pragma unroll
      for (int o = 32; o >= 1; o >>= 1) { mn = fminf(mn, __shfl_xor(mn, o)); mx = fmaxf(mx, __shfl_xor(mx, o)); }
      if (lane == 0) { PMM[2 * t] = mn; PMM[2 * t + 1] = mx; }
    }
  }
  if (nl < DEPTH) {
    bf16_t* MEMN = (bf16_t*)(p.ws + OFF_SM);
    for (int row = blockIdx.x * 4 + w; row < 512; row += gridDim.x * 4) {
      size_t ro = (size_t)row * 1024;
      row_op<false, true>(p.mem + ro, nullptr, nullptr, nullptr, p.g_x_mem + nl * 1024, MEMN + ro, lane);
    }
    convert_weights(p, nl, smem);
  }
}

DI void phase_rows_res(const Params& p, const float* xsrc, const float* gpost, const float* gnext) {
  const int tid_ = opaque_tid(); const int lane = tid_ & 63, w = tid_ >> 6;
  bf16_t* H = (bf16_t*)(p.ws + OFF_H);
  const bf16_t* Y = (const bf16_t*)(p.ws + OFF_Y);
  for (int row = blockIdx.x * 4 + w; row < NTOK; row += gridDim.x * 4) {
    size_t ro = (size_t)row * 1024;
    row_op<true, true>(xsrc + ro, Y + ro, gpost, p.xres + ro, gnext, H + ro, lane);
  }
}

DI void phase_rows_mla(const Params& p, int l) {
  const int tid_ = opaque_tid(); const int lane = tid_ & 63, w = tid_ >> 6;
  const bf16_t* PROJ = (const bf16_t*)(p.ws + OFF_BIG);
  bf16_t* MLAN = (bf16_t*)(p.ws + OFF_Y);
  bf16_t* KB = (bf16_t*)(p.ws + OFF_Y + 48 * MiB);
  const float* gq = p.mla_q_norm_g + l * 256;
  const float* gkv = p.mla_kv_norm_g + l * 128;
  for (int row = blockIdx.x * 4 + w; row < NTOK; row += gridDim.x * 4) {
    const bf16_t* pr = PROJ + (size_t)row * 2048;
    uint2 cq = *(const uint2*)(pr + 768 + lane * 4);
    uint32_t ckv = *(const uint32_t*)(pr + 1024 + lane * 2);
    float q0 = frombf(cq.x & 0xffffu), q1 = frombf(cq.x >> 16), q2 = frombf(cq.y & 0xffffu), q3 = frombf(cq.y >> 16);
    float k0 = frombf(ckv & 0xffffu), k1 = frombf(ckv >> 16);
    float ssq = wave_sum(q0 * q0 + q1 * q1 + q2 * q2 + q3 * q3);
    float ssk = wave_sum(k0 * k0 + k1 * k1);
    float rq = rsqrtf(ssq * (1.f / 256.f) + EPSN), rk = rsqrtf(ssk * (1.f / 128.f) + EPSN);
    float4 g4 = *(const float4*)(gq + lane * 4);
    float2 g2 = *(const float2*)(gkv + lane * 2);
    uint2 u; u.x = pack2(q0 * rq * g4.x, q1 * rq * g4.y); u.y = pack2(q2 * rq * g4.z, q3 * rq * g4.w);
    *(uint2*)(MLAN + (size_t)row * 384 + lane * 4) = u;
    *(uint32_t*)(MLAN + (size_t)row * 384 + 256 + lane * 2) = pack2(k0 * rk * g2.x, k1 * rk * g2.y);
    if (lane < 16) {
      float x1 = frombf(pr[1152 + lane]), x2 = frombf(pr[1152 + 16 + lane]);
      float ang = (float)p.pos[row] * rope_inv(lane);
      float s, c; sincos_red(ang, s, c);
      bf16_t o1 = tobf(x1 * c - x2 * s), o2 = tobf(x1 * s + x2 * c);
      bf16_t* kb = KB + (size_t)row * 384;
#pragma unroll
      for (int hd = 0; hd < 4; ++hd) { kb[hd * 96 + 64 + lane] = o1; kb[hd * 96 + 80 + lane] = o2; }
    }
  }
}

DI void phase_attn(const Params& p, int l, char* smem) {
  const int xcd = blockIdx.x & 7, slot = blockIdx.x >> 3, nslots = gridDim.x >> 3;
  const bf16_t* PROJ = (const bf16_t*)(p.ws + OFF_BIG);
  bf16_t* MIX = (bf16_t*)(p.ws + OFF_BIG + 128 * MiB);
  const bf16_t* QB = (const bf16_t*)(p.ws + OFF_Y + 24 * MiB);
  const bf16_t* KB = (const bf16_t*)(p.ws + OFF_Y + 48 * MiB);
  const bf16_t* VtA = (const bf16_t*)(p.ws + OFF_Y + 72 * MiB);
  const bf16_t* VtB = (const bf16_t*)(p.ws + OFF_Y + 88 * MiB);
  const bf16_t* VtC = (const bf16_t*)(p.ws + OFF_Y + 104 * MiB);
  const float* PMM = (const float*)(p.ws + OFF_SM + 3 * MiB);
  const float* lp = p.diff_lambda + l * 128;
  float d0 = 0.f, d1 = 0.f;
  for (int i = 0; i < 32; ++i) { d0 += lp[i] * lp[32 + i]; d1 += lp[64 + i] * lp[96 + i]; }
  const float lam_init = __uint_as_float(__builtin_amdgcn_readfirstlane(__float_as_uint(0.8f - 0.6f * expf(-0.3f * (float)l))));
  const float lam = __uint_as_float(__builtin_amdgcn_readfirstlane(__float_as_uint(expf(d0) - expf(d1) + lam_init)));
  const int b = xcd >> 2, head = xcd & 3;
  if (ATT_SEL & 1) {
    const float slope2 = exp2f(-8.f * (float)(9 + head) / 12.f) * LOG2E;
    unsigned failA = 0u; int ia = 0;
    for (int qb = slot; qb < 128; qb += nslots, ++ia) {
      const size_t t0 = (size_t)b * SEQ + qb * 128;
      const bool rd = attn_unit<32, 2, 64, 0, true, true>(smem, PROJ + t0 * 2048 + head * 64, 2048, PROJ + (size_t)b * SEQ * 2048 + 256 + head * 64, 2048,
                                    VtA + (size_t)(b * 4 + head) * 64 * SEQ, SEQ, 0, SEQ / 64, p.pos + t0, p.pos + (size_t)b * SEQ, PMM + b * 512, slope2, 0.f, qb * 128,
                                    lam, p.diff_head_g + l * 64, 1.f - lam_init, MIX + t0 * 1024 + head * 64, 1024);
      if (rd) failA |= 1u << ia;
    }
    ia = 0;
    for (int qb = slot; qb < 128; qb += nslots, ++ia) {
      if (!((failA >> ia) & 1u)) continue;
      const size_t t0 = (size_t)b * SEQ + qb * 128;
      (void)attn_unit<32, 2, 64, 0, true, false>(smem, PROJ + t0 * 2048 + head * 64, 2048, PROJ + (size_t)b * SEQ * 2048 + 256 + head * 64, 2048,
                                    VtA + (size_t)(b * 4 + head) * 64 * SEQ, SEQ, 0, SEQ / 64, p.pos + t0, p.pos + (size_t)b * SEQ, PMM + b * 512, slope2, 0.f, qb * 128,
                                    lam, p.diff_head_g + l * 64, 1.f - lam_init, MIX + t0 * 1024 + head * 64, 1024);
    }
  }
  if (ATT_SEL & 2) {
    unsigned failB = 0u; int ib = 0;
    for (int qb = slot; qb < 64; qb += nslots, ++ib) {
      const size_t t0 = (size_t)b * SEQ + qb * 256;
      const bool rd = attn_unit<96, 2, 64, 1, true, true>(smem, QB + t0 * 384 + head * 96, 384, KB + (size_t)b * SEQ * 384 + head * 96, 384,
                                    VtB + (size_t)(b * 4 + head) * 64 * SEQ, SEQ, 0, SEQ / 64, nullptr, nullptr, nullptr, 0.f, 0.f, qb * 256,
                                    0.f, nullptr, 1.f, MIX + t0 * 1024 + 256 + head * 64, 1024);
      if (rd) failB |= 1u << ib;
    }
    ib = 0;
    for (int qb = slot; qb < 64; qb += nslots, ++ib) {
      if (!((failB >> ib) & 1u)) continue;
      const size_t t0 = (size_t)b * SEQ + qb * 256;
      (void)attn_unit<96, 2, 64, 1, true, false>(smem, QB + t0 * 384 + head * 96, 384, KB + (size_t)b * SEQ * 384 + head * 96, 384,
                                    VtB + (size_t)(b * 4 + head) * 64 * SEQ, SEQ, 0, SEQ / 64, nullptr, nullptr, nullptr, 0.f, 0.f, qb * 256,
                                    0.f, nullptr, 1.f, MIX + t0 * 1024 + 256 + head * 64, 1024);
    }
  }
  if (ATT_SEL & 4) for (int j = slot; j < 256; j += nslots) {
    const int hq = (xcd & 3) * 2 + (j >> 7), qb = j & 127, kvh = hq >> 2;
    const size_t t0 = (size_t)b * SEQ + qb * 128;
    const float slope2 = exp2f(-8.f * (float)(hq + 1) / 12.f) * LOG2E;
    const float sink2 = p.swa_sinks[l * 8 + hq] * LOG2E;
    int kt0 = 2 * qb - 2, kt1 = 2 * qb + 4;
    if (kt0 < 0) kt0 = 0;
    if (kt1 > SEQ / 64) kt1 = SEQ / 64;
    (void)attn_unit<64, 1, 64, 2, true, false>(smem, PROJ + t0 * 2048 + 1184 + hq * 64, 2048, PROJ + (size_t)b * SEQ * 2048 + 1696 + kvh * 64, 2048,
                                  VtC + (size_t)(b * 2 + kvh) * 64 * SEQ, SEQ, kt0, kt1, p.pos + t0, p.pos + (size_t)b * SEQ, nullptr, slope2, sink2, qb * 128,
                                  0.f, nullptr, 1.f, MIX + t0 * 1024 + 512 + hq * 64, 1024);
  }
}

DI void phase_xattn(const Params& p, char* smem) {
  const int xcd = blockIdx.x & 7, slot = blockIdx.x >> 3, nslots = gridDim.x >> 3;
  const bf16_t* QX = (const bf16_t*)(p.ws + OFF_BIG);
  bf16_t* OX = (bf16_t*)(p.ws + OFF_BIG + 64 * MiB);
  const bf16_t* KX = (const bf16_t*)(p.ws + OFF_SM + 1 * MiB);
  const bf16_t* VtX = (const bf16_t*)(p.ws + OFF_SM + 2 * MiB);
  const int b = xcd >> 2, head = xcd & 3;
  unsigned failX = 0u; int ix = 0;
  for (int j = slot; j < 256; j += nslots, ++ix) {
    const int dvh = j >> 7, qb = j & 127;
    const size_t t0 = (size_t)b * SEQ + qb * 128;
    const bool rd = attn_unit<256, 1, 128, 3, false, true>(smem, QX + t0 * 1024 + head * 256, 1024, KX + (size_t)b * 256 * 1024 + head * 256, 1024,
                                     VtX + ((size_t)(b * 4 + head) * 256 + dvh * 128) * 256, 256, 0, 4, nullptr, nullptr, nullptr, 0.f, 0.f, 0,
                                     0.f, nullptr, 1.f, OX + t0 * 1024 + head * 256 + dvh * 128, 1024);
    if (rd) failX |= 1u << ix;
  }
  ix = 0;
  for (int j = slot; j < 256; j += nslots, ++ix) {
    if (!((failX >> ix) & 1u)) continue;
    const int dvh = j >> 7, qb = j & 127;
    const size_t t0 = (size_t)b * SEQ + qb * 128;
    (void)attn_unit<256, 1, 128, 3, false, false>(smem, QX + t0 * 1024 + head * 256, 1024, KX + (size_t)b * 256 * 1024 + head * 256, 1024,
                                     VtX + ((size_t)(b * 4 + head) * 256 + dvh * 128) * 256, 256, 0, 4, nullptr, nullptr, nullptr, 0.f, 0.f, 0,
                                     0.f, nullptr, 1.f, OX + t0 * 1024 + head * 256 + dvh * 128, 1024);
  }
}

DI void run_phase(const Params& p, int ph, char* smem) {
  bf16_t* W = (bf16_t*)(p.ws + OFF_W);
  bf16_t* H = (bf16_t*)(p.ws + OFF_H);
  bf16_t* BIG = (bf16_t*)(p.ws + OFF_BIG);
  if (ph == 0) { phase_rows_init_or_res3(p, 0, true, smem); return; }
  const int l = (ph - 1) / 13, s = (ph - 1) % 13;
  switch (s) {
    case 0:
      gemm_phase_g<EPI_PROJ>(p, smem, H, 1024, W + WO_IN, 1024, 256, 8);
      gemm_phase<EPI_XKV>(p, smem, (const bf16_t*)(p.ws + OFF_SM), 1024, W + WO_XKV, 1024, 4, 16, 0);
      break;
    case 1: phase_rows_mla(p, l); break;
    case 2:
      gemm_phase<EPI_QUP>(p, smem, (const bf16_t*)(p.ws + OFF_Y), 384, W + WO_QUP, 256, 256, 3, 1);
      gemm_phase<EPI_KVUP>(p, smem, (const bf16_t*)(p.ws + OFF_Y) + 256, 384, W + WO_KVUP, 128, 256, 4, 1);
      break;
    case 3: phase_attn(p, l, smem); break;
    case 4: gemm_phase_g<EPI_F32>(p, smem, BIG + (size_t)64 * MiB, 1024, W + WO_OUT, 1024, 256, 4); break;
    case 5: phase_rows_res(p, l == 0 ? p.x_in : p.xres, p.g_mix_post + l * 1024, p.g_x_pre + l * 1024); break;
    case 6: gemm_phase_g<EPI_XQ>(p, smem, H, 1024, W + WO_XQ, 1024, 256, 4); break;
    case 7: phase_xattn(p, smem); break;
    case 8: gemm_phase_g<EPI_F32>(p, smem, BIG + (size_t)32 * MiB, 1024, W + WO_XO, 1024, 256, 4); break;
    case 9: phase_rows_res(p, p.xres, p.g_x_post + l * 1024, p.g_ffn_pre + l * 1024); break;
    case 10: gemm_phase_g<EPI_SWIGLU>(p, smem, H, 1024, W + WO_FI, 1024, 256, 22); break;
    case 11: gemm_phase_g<EPI_F32>(p, smem, BIG, DFF, W + WO_FO, DFF, 256, 4); break;
    case 12: phase_rows_init_or_res3(p, l, false, smem); break;
  }
}

constexpr int NPHASES = 1 + 13 * DEPTH;

__global__ void __launch_bounds__(NTHREADS, 2) fwd_megakernel(Params p) {
  __shared__ __attribute__((aligned(16))) char smem[SMEM_BYTES];
  __shared__ uint4 xb_words;
  cg::grid_group grid = cg::this_grid();
  if (threadIdx.x == 0) xb_words = make_uint4(0u, 0u, 0u, 0u);
  __syncthreads();
  XcdBarrier xb = xcd_barrier_post((unsigned*)(p.ws + OFF_BAR), (volatile LAS unsigned*)&xb_words);
  for (int ph = p.phase_begin; ph < p.phase_end; ++ph) {
    {
#if defined(__HIP_DEVICE_COMPILE__)
      typedef const Params __attribute__((address_space(4)))* KargPtr;
      KargPtr pp = (KargPtr)__builtin_amdgcn_kernarg_segment_ptr();
      asm volatile("" : "+s"(pp));
      const Params q = *pp;
#else
      const Params q = p;
#endif
      run_phase(q, ph, smem);
#if PROBE_DUP
      if (ph > 0 && ((PROBE_DUP >> ((ph - 1) % 13)) & 1)) { __syncthreads(); run_phase(q, ph, smem); }
#endif
    }
    if (ph + 1 < p.phase_end) {
      if (p.phase_begin < 0) grid.sync();
      xcd_barrier(xb);
    }
  }
}

extern "C" void kernel_launch(void* const* d_in, const int* in_sizes, int n_in, void* d_out, int out_size, void* d_ws, size_t ws_size,
                              hipStream_t stream) {
  static int grid_blocks = 0;
  if (!grid_blocks) {
    int dev = 0, cus = 0, per_cu = 0;
    hipGetDevice(&dev);
    hipDeviceGetAttribute(&cus, hipDeviceAttributeMultiprocessorCount, dev);
    hipOccupancyMaxActiveBlocksPerMultiprocessor(&per_cu, fwd_megakernel, NTHREADS, 0);
    if (per_cu > 2) per_cu = 2;
    if (per_cu < 1) per_cu = 1;
    grid_blocks = cus * per_cu;
    grid_blocks &= ~7;
  }
  Params p{};
  p.x_in = (const float*)d_in[0]; p.mem = (const float*)d_in[1]; p.pos = (const int*)d_in[2];
  p.g_mix_pre = (const float*)d_in[3]; p.g_mix_post = (const float*)d_in[4]; p.w_in = (const float*)d_in[5];
  p.diff_lambda = (const float*)d_in[6]; p.diff_head_g = (const float*)d_in[7]; p.mla_q_norm_g = (const float*)d_in[8];
  p.mla_w_q_up = (const float*)d_in[9]; p.mla_kv_norm_g = (const float*)d_in[10]; p.mla_w_kv_up = (const float*)d_in[11];
  p.swa_sinks = (const float*)d_in[12]; p.w_out = (const float*)d_in[13]; p.g_x_pre = (const float*)d_in[14];
  p.g_x_mem = (const float*)d_in[15]; p.g_x_post = (const float*)d_in[16]; p.w_xq = (const float*)d_in[17];
  p.w_xkv = (const float*)d_in[18]; p.w_xo = (const float*)d_in[19]; p.g_ffn_pre = (const float*)d_in[20];
  p.g_ffn_post = (const float*)d_in[21]; p.w_ffn_in = (const float*)d_in[22]; p.w_ffn_out = (const float*)d_in[23];
  p.xres = (float*)d_out; p.ws = (char*)d_ws;
#if SINGLE_LAUNCH
  hipMemsetAsync((char*)d_ws + OFF_BAR, 0, XCD_BAR_WORDS * sizeof(unsigned), stream);
  p.phase_begin = 0; p.phase_end = NPHASES;
  void* args[] = {&p};
  hipError_t e = hipLaunchCooperativeKernel((void*)fwd_megakernel, dim3(grid_blocks), dim3(NTHREADS), args, 0, stream);
  if (e != hipSuccess) fprintf(stderr, "cooperative launch failed: %s (grid %d)\n", hipGetErrorString(e), grid_blocks);
#else
  for (int ph = 0; ph < NPHASES; ++ph) {
    p.phase_begin = ph; p.phase_end = ph + 1;
    fwd_megakernel<<<dim3(grid_blocks), dim3(NTHREADS), 0, stream>>>(p);
  }
#endif
}
```
